# Optimizing an MI355X kernel written in HIP

```python
import math
import jax, jax.numpy as jnp
from jax import lax
import numpy as np

D_MODEL = 1024
BATCH = 4
SEQ = 8192
DEPTH = 2

CHUNK = 64
HEAD_DIM = 64
N_HEADS_FOX = 8
N_HEADS_CHUNK = 8
WIDTH_FOX = N_HEADS_FOX * HEAD_DIM
WIDTH_CHUNK = N_HEADS_CHUNK * HEAD_DIM
LEFT_CHUNKS = 8
BAND_CHUNKS = LEFT_CHUNKS + 1
REL_CLIP = 128
Q_BLOCK = 128
D_FF = 2816
CONV_WIDTH = 3
LN_EPS = 1e-5
N_MOD = 6
PROJ_SIZES = (WIDTH_FOX, WIDTH_FOX, WIDTH_FOX, N_HEADS_FOX,
              WIDTH_CHUNK, WIDTH_CHUNK, WIDTH_CHUNK, D_MODEL, D_MODEL)
PROJ_COLS = sum(PROJ_SIZES)

kernel_name = "fox_chunkattn_gated_hybrid_deepnorm_adaln"


def _layer_norm(x, gain=None, bias=None):
    xf = x.astype(jnp.float32)
    mu = jnp.mean(xf, axis=-1, keepdims=True)
    var = jnp.mean(jnp.square(xf - mu), axis=-1, keepdims=True)
    y = (xf - mu) * lax.rsqrt(var + LN_EPS)
    if gain is not None:
        y = y * gain.astype(jnp.float32) + bias.astype(jnp.float32)
    return y.astype(x.dtype)


def _forgetting_attention(q, k, v, f_logit):
    b, s, h, dh = q.shape
    n_blk = s // Q_BLOCK
    log_f = jax.nn.log_sigmoid(f_logit.astype(jnp.float32))
    cum = jnp.cumsum(log_f, axis=1).transpose(0, 2, 1)
    scale = 1.0 / math.sqrt(dh)
    k_pos = jnp.arange(s)
    q_blocks = q.reshape(b, n_blk, Q_BLOCK, h, dh).transpose(1, 0, 2, 3, 4)
    cum_blocks = cum.reshape(b, h, n_blk, Q_BLOCK).transpose(2, 0, 1, 3)
    neg = jnp.finfo(jnp.float32).min

    def block(args):
        qb, cq, i = args
        q_pos = i * Q_BLOCK + jnp.arange(Q_BLOCK)
        logits = jnp.einsum('bqhd,bkhd->bhqk', qb, k).astype(jnp.float32) * scale
        logits = logits + cq[:, :, :, None] - cum[:, :, None, :]
        mask = k_pos[None, :] <= q_pos[:, None]
        logits = jnp.where(mask[None, None], logits, neg)
        p = jax.nn.softmax(logits, axis=-1).astype(v.dtype)
        return jnp.einsum('bhqk,bkhd->bqhd', p, v)

    out = lax.map(block, (q_blocks, cum_blocks, jnp.arange(n_blk)))
    return out.transpose(1, 0, 2, 3, 4).reshape(b, s, h * dh)


def _chunk_band_attention(q, k, v, rel_table):
    b, s, h, dh = q.shape
    n_c = s // CHUNK
    band = BAND_CHUNKS * CHUNK
    qc = q.reshape(b, n_c, CHUNK, h, dh)
    pad = ((0, 0), (LEFT_CHUNKS, 0), (0, 0), (0, 0), (0, 0))
    kp = jnp.pad(k.reshape(b, n_c, CHUNK, h, dh), pad)
    vp = jnp.pad(v.reshape(b, n_c, CHUNK, h, dh), pad)
    band_idx = jnp.arange(n_c)[:, None] + jnp.arange(BAND_CHUNKS)[None, :]
    kb = kp[:, band_idx].reshape(b, n_c, band, h, dh)
    vb = vp[:, band_idx].reshape(b, n_c, band, h, dh)
    valid = jnp.repeat(band_idx >= LEFT_CHUNKS, CHUNK, axis=1)
    q_off = LEFT_CHUNKS * CHUNK + np.arange(CHUNK)
    rel = np.clip(q_off[:, None] - np.arange(band)[None, :], -REL_CLIP, REL_CLIP) + REL_CLIP
    bias = rel_table[:, rel].astype(jnp.float32)
    scale = 1.0 / math.sqrt(dh)
    logits = jnp.einsum('bcqhd,bckhd->bchqk', qc, kb).astype(jnp.float32) * scale
    logits = logits + bias[None, None]
    logits = jnp.where(valid[None, :, None, None, :], logits, jnp.finfo(jnp.float32).min)
    p = jax.nn.softmax(logits, axis=-1).astype(v.dtype)
    out = jnp.einsum('bchqk,bckhd->bcqhd', p, vb)
    return out.reshape(b, s, h * dh)


def _causal_depthwise_conv(u, w, bias):
    s = u.shape[1]
    up = jnp.pad(u, ((0, 0), (CONV_WIDTH - 1, 0), (0, 0)))
    y = bias
    for j in range(CONV_WIDTH):
        y = y + w[j] * up[:, j:j + s]
    return y


def setup_inputs(seed: int = 0) -> dict:
    key = jax.random.key(seed)
    ks = jax.random.split(key, 20)
    beta = (8.0 * DEPTH) ** -0.25
    f32 = jnp.float32
    nrm = lambda k, shape: jax.random.normal(k, shape, f32)
    col_scale = np.concatenate([
        np.ones(2 * WIDTH_FOX), beta * np.ones(WIDTH_FOX), 0.5 * np.ones(N_HEADS_FOX),
        np.ones(2 * WIDTH_CHUNK), beta * np.ones(WIDTH_CHUNK), np.ones(2 * D_MODEL)]).astype(np.float32)
    w_in = nrm(ks[2], (DEPTH, D_MODEL, PROJ_COLS)) * (D_MODEL ** -0.5) * jnp.asarray(col_scale)
    b_f = jnp.linspace(1.0, 5.0, N_HEADS_FOX, dtype=f32)[None, :] + 0.1 * nrm(ks[3], (DEPTH, N_HEADS_FOX))
    rel_bias = 0.5 * nrm(ks[4], (DEPTH, N_HEADS_CHUNK, 2 * REL_CLIP + 1))
    w_br_fox = nrm(ks[5], (DEPTH, WIDTH_FOX, D_MODEL)) * WIDTH_FOX ** -0.5
    w_br_chunk = nrm(ks[6], (DEPTH, WIDTH_CHUNK, D_MODEL)) * WIDTH_CHUNK ** -0.5
    w_out = nrm(ks[7], (DEPTH, D_MODEL, D_MODEL)) * (D_MODEL ** -0.5) * beta
    w_up = nrm(ks[8], (DEPTH, D_MODEL, 2 * D_FF)) * D_MODEL ** -0.5
    conv_w = 0.3 * nrm(ks[9], (DEPTH, CONV_WIDTH, 2 * D_FF)) + jnp.array([0.0, 0.0, 1.0], f32)[None, :, None]
    conv_b = 0.01 * nrm(ks[10], (DEPTH, 2 * D_FF))
    w_down = nrm(ks[11], (DEPTH, D_FF, D_MODEL)) * (D_FF ** -0.5) * beta
    w_ada = 0.2 * nrm(ks[12], (DEPTH, D_MODEL, N_MOD * D_MODEL)) * D_MODEL ** -0.5
    b_ada = 0.01 * nrm(ks[13], (DEPTH, N_MOD * D_MODEL))
    ln1_g = 1.0 + 0.05 * nrm(ks[14], (DEPTH, D_MODEL))
    ln1_b = 0.01 * nrm(ks[15], (DEPTH, D_MODEL))
    ln2_g = 1.0 + 0.05 * nrm(ks[16], (DEPTH, D_MODEL))
    ln2_b = 0.01 * nrm(ks[17], (DEPTH, D_MODEL))
    x = nrm(ks[0], (BATCH, SEQ, D_MODEL))
    c = nrm(ks[1], (BATCH, D_MODEL))
    return {"x": x, "c": c, "w_in": w_in, "b_f": b_f, "rel_bias": rel_bias,
            "w_br_fox": w_br_fox, "w_br_chunk": w_br_chunk, "w_out": w_out,
            "w_up": w_up, "conv_w": conv_w, "conv_b": conv_b, "w_down": w_down,
            "w_ada": w_ada, "b_ada": b_ada, "ln1_g": ln1_g, "ln1_b": ln1_b,
            "ln2_g": ln2_g, "ln2_b": ln2_b}


def reference(x, c, w_in, b_f, rel_bias, w_br_fox, w_br_chunk, w_out, w_up, conv_w,
              conv_b, w_down, w_ada, b_ada, ln1_g, ln1_b, ln2_g, ln2_b):
    alpha = (2.0 * DEPTH) ** 0.25
    b, s, _ = x.shape
    split_points = list(np.cumsum(PROJ_SIZES)[:-1])
    cond = jax.nn.silu(c)
    for l in range(DEPTH):
        mod = cond @ w_ada[l] + b_ada[l]
        sh1, sc1, g1, sh2, sc2, g2 = jnp.split(mod[:, None, :], N_MOD, axis=-1)

        h = _layer_norm(x) * (1.0 + sc1) + sh1
        proj = h @ w_in[l]
        q_a, k_a, v_a, f_a, q_c, k_c, v_c, gate_a, gate_c = jnp.split(proj, split_points, axis=-1)
        heads_a = lambda t: t.reshape(b, s, N_HEADS_FOX, HEAD_DIM)
        heads_c = lambda t: t.reshape(b, s, N_HEADS_CHUNK, HEAD_DIM)
        o_a = _forgetting_attention(heads_a(q_a), heads_a(k_a), heads_a(v_a), f_a + b_f[l])
        o_c = _chunk_band_attention(heads_c(q_c), heads_c(k_c), heads_c(v_c), rel_bias[l])
        merged = (jax.nn.sigmoid(gate_a) * (o_a @ w_br_fox[l])
                  + jax.nn.sigmoid(gate_c) * (o_c @ w_br_chunk[l]))
        mix = merged @ w_out[l]
        x = _layer_norm(alpha * x + (1.0 + g1) * mix, ln1_g[l], ln1_b[l])

        h = _layer_norm(x) * (1.0 + sc2) + sh2
        u = _causal_depthwise_conv(h @ w_up[l], conv_w[l], conv_b[l])
        a, val = jnp.split(u, 2, axis=-1)
        y = (jax.nn.silu(a) * val) @ w_down[l]
        x = _layer_norm(alpha * x + (1.0 + g2) * y, ln2_g[l], ln2_b[l])
    return x
```

```cpp
#include <hip/hip_runtime.h>
#include <hip/hip_cooperative_groups.h>
#include <cstdio>
#include <cstdint>
namespace cg = cooperative_groups;

namespace pg8 {
#define PG8_LAS __attribute__((address_space(3)))
typedef unsigned short bf16_t;
typedef short bf16x8 __attribute__((ext_vector_type(8)));
typedef float f32x4 __attribute__((ext_vector_type(4)));
typedef unsigned u32x4 __attribute__((ext_vector_type(4)));
typedef unsigned u32x2 __attribute__((ext_vector_type(2)));
constexpr int BM = 256, BK = 64, HALF = 128, HTB = HALF * BK * 2  , STAGE_BYTES = 8 * HTB, NXCD = 8, WGM = 8;

__host__ __device__ __forceinline__ int lds_byte(int r, int c) { const int st = (r >> 4) * 2 + (c >> 5), rr = r & 15, cc = c & 31, ob = rr * 64 + cc * 2; return st * 1024 + (ob ^ (((ob >> 9) & 1) << 5)); }
__host__ __device__ __forceinline__ void stage_rc(int b, int& R, int& C) { const int st = b / 1024, sb = b % 1024, swz = sb ^ (((sb >> 9) & 1) << 5); R = (st >> 1) * 16 + swz / 64; C = (st & 1) * 32 + (swz % 64) / 2; }
__host__ __device__ __forceinline__ int perm32(int rho) { const int n = rho >> 4, i = rho & 15; return 8 * (i >> 2) + 4 * n + (i & 3); }

struct Unit { int pm, pn; };
struct Gemm { const bf16_t* A; const bf16_t* Bt; int M, N, K, lda, ldb; };

struct StaticOrder {
    int nM, nN, nwg, G, c;
    __host__ __device__ void init(int M, int N, int G_, int c_) { nM = M / BM; nN = N / BM; nwg = nM * nN; G = G_; c = c_; }
    __host__ __device__ bool next(int i, Unit& u) const {
        const long L = (long)i * G + c; if (L >= nwg) return false;
        int wgid = (int)L; { const int q = nwg / NXCD, r = nwg % NXCD, xcd = wgid % NXCD, off = wgid / NXCD; wgid = (xcd < r ? xcd * (q + 1) : r * (q + 1) + (xcd - r) * q) + off; }
        const int nig = WGM * nN, gid = wgid / nig, fm = gid * WGM, gsz = (nM - fm) < WGM ? (nM - fm) : WGM;
        u.pm = fm + ((wgid % nig) % gsz); u.pn = (wgid % nig) / gsz; return true;
    }
    __device__ __forceinline__ void a_ready(const Unit&) const {}
    __device__ __forceinline__ void done(const Unit&) const {}
};

__device__ __forceinline__ unsigned cvt_pk_bf16(float lo, float hi) { unsigned r; asm volatile("v_cvt_pk_bf16_f32 %0, %1, %2" : "=v"(r) : "v"(lo), "v"(hi)); return r; }
__device__ __forceinline__ float bf_lo(unsigned w) { return __uint_as_float(w << 16); }
__device__ __forceinline__ float bf_hi(unsigned w) { return __uint_as_float(w & 0xffff0000u); }
__device__ __forceinline__ float sigmoidf_fast(float v) { return __builtin_amdgcn_rcpf(1.0f + __builtin_amdgcn_exp2f(-1.4426950408889634f * v)); }
constexpr float ATT_C2 = 0.125f * 1.4426950408889634f;

struct EpiProj {
    static constexpr bool PERM = true, AFTER_DRAIN = false, MIDK = false;
    bf16_t *QQ, *KK, *VV, *GG;
    __device__ __forceinline__ void operator()(const f32x4 (&acc)[2][2][4][2], const Unit& u, int wr, int wc, int fr, int fq) const {
        const int row0 = u.pm * BM + wr * 64 + fr; const int pn = u.pn;
        bf16_t* base; int ldc = 1024, colt; float sc = 1.f; bool sig = false;
        if (pn < 4) { base = QQ; colt = pn * 256; sc = ATT_C2; } else if (pn < 8) { base = KK; colt = (pn - 4) * 256; } else if (pn < 12) { base = VV; colt = (pn - 8) * 256; }
        else { base = GG; ldc = 2048; colt = (pn - 12) * 256; sig = true; }
        const int col0 = colt + wc * 32 + 8 * fq;
#pragma unroll
        for (int ai = 0; ai < 2; ++ai)
#pragma unroll
            for (int m = 0; m < 4; ++m) { bf16_t* rowp = base + (size_t)(row0 + ai * HALF + m * 16) * ldc + col0;
#pragma unroll
                for (int bj = 0; bj < 2; ++bj) { f32x4 v0 = acc[ai][bj][m][0], v1 = acc[ai][bj][m][1];
                    if (sig) {
#pragma unroll
                        for (int e = 0; e < 4; ++e) { v0[e] = sigmoidf_fast(v0[e]); v1[e] = sigmoidf_fast(v1[e]); } }
                    else { v0 = v0 * sc; v1 = v1 * sc; }
                    u32x4 w; w.x = cvt_pk_bf16(v0[0], v0[1]); w.y = cvt_pk_bf16(v0[2], v0[3]); w.z = cvt_pk_bf16(v1[0], v1[1]); w.w = cvt_pk_bf16(v1[2], v1[3]);
                    *(u32x4*)(rowp + bj * HALF) = w; } }
    }
};
struct EpiMergeK {
    static constexpr bool PERM = true, AFTER_DRAIN = false, MIDK = true;
    bf16_t* MG; const bf16_t* GG;
    __device__ __forceinline__ void mid(f32x4 (&acc)[2][2][4][2], const Unit& u, int wr, int wc, int fr, int fq) const {
        int row0 = u.pm * BM + wr * 64 + fr; int col0 = u.pn * BM + wc * 32 + 8 * fq;
        asm volatile("" : "+v"(row0), "+v"(col0));
#pragma unroll
        for (int ai = 0; ai < 2; ++ai)
#pragma unroll
            for (int m = 0; m < 4; ++m) { if ((m & 1) == 0) asm volatile("" ::: "memory"); const size_t r = (size_t)(row0 + ai * HALF + m * 16);
#pragma unroll
                for (int bj = 0; bj < 2; ++bj) { const int c = col0 + bj * HALF;
                    const u32x4 ga = *(const u32x4*)(GG + r * 2048 + c), gc = *(const u32x4*)(GG + r * 2048 + 1024 + c);
                    f32x4& v0 = acc[ai][bj][m][0]; f32x4& v1 = acc[ai][bj][m][1];
                    v0[0] *= bf_lo(ga.x) * __builtin_amdgcn_rcpf(bf_lo(gc.x)); v0[1] *= bf_hi(ga.x) * __builtin_amdgcn_rcpf(bf_hi(gc.x));
                    v0[2] *= bf_lo(ga.y) * __builtin_amdgcn_rcpf(bf_lo(gc.y)); v0[3] *= bf_hi(ga.y) * __builtin_amdgcn_rcpf(bf_hi(gc.y));
                    v1[0] *= bf_lo(ga.z) * __builtin_amdgcn_rcpf(bf_lo(gc.z)); v1[1] *= bf_hi(ga.z) * __builtin_amdgcn_rcpf(bf_hi(gc.z));
                    v1[2] *= bf_lo(ga.w) * __builtin_amdgcn_rcpf(bf_lo(gc.w)); v1[3] *= bf_hi(ga.w) * __builtin_amdgcn_rcpf(bf_hi(gc.w)); } }
    }
    __device__ __forceinline__ void operator()(const f32x4 (&acc)[2][2][4][2], const Unit& u, int wr, int wc, int fr, int fq) const {
        const int row0 = u.pm * BM + wr * 64 + fr; const int col0 = u.pn * BM + wc * 32 + 8 * fq;
#pragma unroll
        for (int ai = 0; ai < 2; ++ai)
#pragma unroll
            for (int m = 0; m < 4; ++m) { const size_t r = (size_t)(row0 + ai * HALF + m * 16);
#pragma unroll
                for (int bj = 0; bj < 2; ++bj) { const int c = col0 + bj * HALF;
                    const u32x4 gw = *(const u32x4*)(GG + r * 2048 + 1024 + c);
                    f32x4 v0 = acc[ai][bj][m][0], v1 = acc[ai][bj][m][1];
                    v0[0] *= bf_lo(gw.x); v0[1] *= bf_hi(gw.x); v0[2] *= bf_lo(gw.y); v0[3] *= bf_hi(gw.y);
                    v1[0] *= bf_lo(gw.z); v1[1] *= bf_hi(gw.z); v1[2] *= bf_lo(gw.w); v1[3] *= bf_hi(gw.w);
                    u32x4 w; w.x = cvt_pk_bf16(v0[0], v0[1]); w.y = cvt_pk_bf16(v0[2], v0[3]); w.z = cvt_pk_bf16(v1[0], v1[1]); w.w = cvt_pk_bf16(v1[2], v1[3]);
                    *(u32x4*)(MG + r * 1024 + c) = w; } }
    }
};
struct EpiF32 {
    static constexpr bool PERM = false, AFTER_DRAIN = false, MIDK = false;
    float* out; int ldc;
    __device__ __forceinline__ void operator()(const f32x4 (&acc)[2][2][4][2], const Unit& u, int wr, int wc, int fr, int fq) const {
        const int row0 = u.pm * BM + wr * 64 + fr; const int col0 = u.pn * BM + wc * 32 + 4 * fq;
#pragma unroll
        for (int ai = 0; ai < 2; ++ai)
#pragma unroll
            for (int m = 0; m < 4; ++m) { float* rowp = out + (size_t)(row0 + ai * HALF + m * 16) * ldc + col0;
#pragma unroll
                for (int bj = 0; bj < 2; ++bj)
#pragma unroll
                    for (int n = 0; n < 2; ++n) *(f32x4*)(rowp + bj * HALF + n * 16) = acc[ai][bj][m][n]; }
    }
};
#ifndef DPP_ROR1
#define DPP_ROR1 0x121
#define DPP_ROR2 0x122
#endif
template <int CTRL> __device__ __forceinline__ float dpp_ror(float v) { return __builtin_bit_cast(float, __builtin_amdgcn_update_dpp(0, __builtin_bit_cast(int, v), CTRL, 0xf, 0xf, false)); }
struct EpiBf16P {
    static constexpr bool PERM = true, AFTER_DRAIN = false, MIDK = false;
    bf16_t* out; int ldc;
    __device__ __forceinline__ void operator()(const f32x4 (&acc)[2][2][4][2], const Unit& u, int wr, int wc, int fr, int fq) const {
        const int row0 = u.pm * BM + wr * 64 + fr; const int col0 = u.pn * BM + wc * 32 + 8 * fq;
#pragma unroll
        for (int ai = 0; ai < 2; ++ai)
#pragma unroll
            for (int m = 0; m < 4; ++m) { bf16_t* rowp = out + (size_t)(row0 + ai * HALF + m * 16) * ldc + col0;
#pragma unroll
                for (int bj = 0; bj < 2; ++bj) { const f32x4 v0 = acc[ai][bj][m][0], v1 = acc[ai][bj][m][1];
                    u32x4 w; w.x = cvt_pk_bf16(v0[0], v0[1]); w.y = cvt_pk_bf16(v0[2], v0[3]); w.z = cvt_pk_bf16(v1[0], v1[1]); w.w = cvt_pk_bf16(v1[2], v1[3]);
                    *(u32x4*)(rowp + bj * HALF) = w; } }
    }
};
struct EpiUp {
    static constexpr bool PERM = true, AFTER_DRAIN = false, MIDK = false;
    bf16_t* GF; float* HD; float* TL; const float* cw; const float* cb;
    __device__ __forceinline__ void operator()(const f32x4 (&acc)[2][2][4][2], const Unit& u, int wr, int wc, int fr, int fq) const {
        const int lane = fq * 16 + fr;
        const int colA0 = u.pn * 128 + wc * 32 + 8 * fq;
#pragma unroll
        for (int n = 0; n < 2; ++n) {
            asm volatile("" ::: "memory");
            const int ca = colA0 + 4 * n;
            const f32x4 w0a = *(const f32x4*)(cw + ca), w1a = *(const f32x4*)(cw + 5632 + ca), w2a = *(const f32x4*)(cw + 2 * 5632 + ca), ba = *(const f32x4*)(cb + ca);
            const f32x4 w0v = *(const f32x4*)(cw + 2816 + ca), w1v = *(const f32x4*)(cw + 5632 + 2816 + ca), w2v = *(const f32x4*)(cw + 2 * 5632 + 2816 + ca), bv = *(const f32x4*)(cb + 2816 + ca);
#pragma unroll
            for (int ai = 0; ai < 2; ++ai) {
                const int rowg = u.pm * BM + ai * HALF + wr * 64; const int grp = rowg >> 6;
                f32x4 pa1 = (f32x4){0.f, 0.f, 0.f, 0.f}, pa2 = pa1, pv1 = pa1, pv2 = pa1;
#pragma unroll
                for (int m = 0; m < 4; ++m) {
                    const f32x4 ua = acc[ai][0][m][n], uv = acc[ai][1][m][n];
                    f32x4 ra1, ra2, rv1, rv2;
#pragma unroll
                    for (int e = 0; e < 4; ++e) { ra1[e] = dpp_ror<DPP_ROR1>(ua[e]); ra2[e] = dpp_ror<DPP_ROR2>(ua[e]); rv1[e] = dpp_ror<DPP_ROR1>(uv[e]); rv2[e] = dpp_ror<DPP_ROR2>(uv[e]); }
                    const f32x4 a1 = fr >= 1 ? ra1 : pa1, a2 = fr >= 2 ? ra2 : pa2, v1 = fr >= 1 ? rv1 : pv1, v2 = fr >= 2 ? rv2 : pv2;
                    const f32x4 ya = ba + w2a * ua + w1a * a1 + w0a * a2, yv = bv + w2v * uv + w1v * v1 + w0v * v2;
                    float g[4];
#pragma unroll
                    for (int e = 0; e < 4; ++e) g[e] = ya[e] * sigmoidf_fast(ya[e]) * yv[e];
                    u32x2 w; w.x = cvt_pk_bf16(g[0], g[1]); w.y = cvt_pk_bf16(g[2], g[3]);
                    *(u32x2*)(GF + (size_t)(rowg + m * 16 + fr) * 2816 + ca) = w;
                    if (m == 0 && fr < 2) { float* p = HD + (size_t)(grp * 2 + fr) * 5632 + ca; *(f32x4*)p = ua; *(f32x4*)(p + 2816) = uv; }
                    if (m == 3 && fr >= 14) { float* p = TL + (size_t)(grp * 2 + fr - 14) * 5632 + ca; *(f32x4*)p = ua; *(f32x4*)(p + 2816) = uv; }
                    pa1 = ra1; pa2 = ra2; pv1 = rv1; pv2 = rv2;
                }
            }
        }
    }
};

template <class Epi, class Sched, bool ALIGN_EPI = false, bool SP2 = false>
__device__ __forceinline__ void gemm_phase(PG8_LAS unsigned char* lds, const Gemm g, const Sched& S, const Epi& E) {
    int tid_ = threadIdx.x; asm volatile("" : "+v"(tid_)); const int tid = tid_, wid = __builtin_amdgcn_readfirstlane(tid >> 6), lane = tid & 63, wr = wid >> 2, wc = wid & 3, fr = lane & 15, fq = lane >> 4;
    const int K = g.K, nt = K / BK;
    unsigned voffA[2], voffB[2];
#pragma unroll
    for (int i = 0; i < 2; ++i) { int R, C; stage_rc(tid * 16 + i * 8192, R, C); const int Rb = Epi::PERM ? ((R & ~31) + perm32(R & 31)) : R;
        voffA[i] = (unsigned)(R * g.lda + C) * 2u; voffB[i] = (unsigned)(Rb * g.ldb + C) * 2u; }
    const size_t kstep = (size_t)(BK * 2);
    const size_t hstepA = (size_t)HALF * g.lda * 2, hstepB = (size_t)HALF * g.ldb * 2;
    const size_t tstepA = 2 * hstepA, tstepB = 2 * hstepB;
    const unsigned ldsw = (unsigned)wid * 1024u;
    const int aoff = lds_byte(wr * 64 + fr, fq * 8), boff = lds_byte(wc * 32 + fr, fq * 8);
#define PG8_SA(b, h) (((b) * 2 + (h)) * HTB)
#define PG8_SB(b, h) ((4 + (b) * 2 + (h)) * HTB)
#define PG8_STAGE(bufoff, gbase, voff) do { _Pragma("unroll") for (int _i = 0; _i < 2; ++_i) \
        __builtin_amdgcn_global_load_lds((const unsigned*)((const char*)(gbase) + (voff)[_i]), (PG8_LAS unsigned*)(lds + (bufoff) + ldsw + _i * 8192), 16, 0, 0); } while (0)
#define PG8_LDA(dst, b, h) do { _Pragma("unroll") for (int m = 0; m < 4; ++m) _Pragma("unroll") for (int k = 0; k < 2; ++k) dst[m][k] = *(const PG8_LAS bf16x8*)(lds + PG8_SA(b, h) + aoff + m * 2048 + k * 1024); } while (0)
#define PG8_LDB(dst, b, h) do { _Pragma("unroll") for (int n = 0; n < 2; ++n) _Pragma("unroll") for (int k = 0; k < 2; ++k) dst[n][k] = *(const PG8_LAS bf16x8*)(lds + PG8_SB(b, h) + boff + n * 2048 + k * 1024); } while (0)
#define PG8_MMA(ai, bj, At, Bt) do { __builtin_amdgcn_s_setprio(1); _Pragma("unroll") for (int m = 0; m < 4; ++m) _Pragma("unroll") for (int n = 0; n < 2; ++n) _Pragma("unroll") for (int k = 0; k < 2; ++k) \
        acc[ai][bj][m][n] = __builtin_amdgcn_mfma_f32_16x16x32_bf16(Bt[n][k], At[m][k], acc[ai][bj][m][n], 0, 0, 0); __builtin_amdgcn_s_setprio(0); } while (0)
#define PG8_WAIT_V(n) asm volatile("s_waitcnt vmcnt(" #n ")" ::: "memory")
#define PG8_WAIT_L(n) asm volatile("s_waitcnt lgkmcnt(" #n ")" ::: "memory")
#define PG8_BAR __builtin_amdgcn_s_barrier()
#define PG8_SCHED __builtin_amdgcn_sched_barrier(0)
    Unit cur, nxt; int ui = 0;
    if (!S.next(0, cur)) return;
    f32x4 acc[2][2][4][2];
#pragma unroll
    for (int a = 0; a < 2; ++a)
#pragma unroll
        for (int b = 0; b < 2; ++b)
#pragma unroll
            for (int m = 0; m < 4; ++m)
#pragma unroll
                for (int n = 0; n < 2; ++n) acc[a][b][m][n] = (f32x4){0.f, 0.f, 0.f, 0.f};
    bf16x8 At[4][2], B0[2][2], B1[2][2];
    const char* cA = (const char*)g.A + (size_t)cur.pm * tstepA; const char* cB = (const char*)g.Bt + (size_t)cur.pn * tstepB;
    S.a_ready(cur);
    if constexpr (SP2) {
        PG8_STAGE(PG8_SB(0, 0), cB, voffB); PG8_STAGE(PG8_SB(0, 1), cB + hstepB, voffB); PG8_STAGE(PG8_SA(0, 0), cA, voffA); PG8_STAGE(PG8_SA(0, 1), cA + hstepA, voffA);
        if (wr == 1) PG8_BAR;
        PG8_WAIT_V(2); PG8_BAR;
        PG8_STAGE(PG8_SB(1, 0), cB + kstep, voffB); PG8_STAGE(PG8_SA(1, 0), cA + kstep, voffA); PG8_STAGE(PG8_SB(1, 1), cB + hstepB + kstep, voffB);
        PG8_WAIT_V(6); PG8_BAR;
    } else {
        PG8_STAGE(PG8_SB(0, 0), cB, voffB); PG8_STAGE(PG8_SA(0, 0), cA, voffA); PG8_STAGE(PG8_SB(0, 1), cB + hstepB, voffB); PG8_STAGE(PG8_SA(0, 1), cA + hstepA, voffA);
        if (wr == 1) PG8_BAR;
        PG8_WAIT_V(4); PG8_BAR;
        PG8_STAGE(PG8_SB(1, 0), cB + kstep, voffB); PG8_STAGE(PG8_SA(1, 0), cA + kstep, voffA); PG8_STAGE(PG8_SB(1, 1), cB + hstepB + kstep, voffB);
        PG8_WAIT_V(6); PG8_BAR;
    }
    for (;;) {
        const bool has_next = S.next(ui + 1, nxt);
        const char* nA = has_next ? (const char*)g.A + (size_t)nxt.pm * tstepA : cA; const char* nB = has_next ? (const char*)g.Bt + (size_t)nxt.pn * tstepB : cB;
        for (int t = 0; t < nt; t += 2) {
            const bool last = (t == nt - 2);
            const char* a1 = cA + (size_t)(t + 1) * kstep;
            const char* a2 = last ? nA : cA + (size_t)(t + 2) * kstep; const char* b2 = last ? nB : cB + (size_t)(t + 2) * kstep;
            const char* a3 = a2 + kstep; const char* b3 = b2 + kstep;
            if (last && has_next) S.a_ready(nxt);
            if constexpr (Epi::MIDK) { if (t == (nt >> 1)) E.mid(acc, cur, wr, wc, fr, fq); }
            if constexpr (SP2) {
            PG8_LDB(B0, 0, 0); PG8_LDB(B1, 0, 1); PG8_SCHED; PG8_LDA(At, 0, 0); PG8_STAGE(PG8_SA(1, 1), a1 + hstepA, voffA);
            PG8_WAIT_V(8); PG8_WAIT_L(0); PG8_BAR; PG8_MMA(0, 0, At, B0); PG8_MMA(0, 1, At, B1); PG8_BAR; PG8_SCHED;
            PG8_LDA(At, 0, 1); PG8_STAGE(PG8_SB(0, 0), b2, voffB); PG8_STAGE(PG8_SB(0, 1), b2 + hstepB, voffB); PG8_STAGE(PG8_SA(0, 0), a2, voffA);
            PG8_WAIT_V(8); PG8_WAIT_L(0); PG8_BAR; PG8_MMA(1, 0, At, B0); PG8_MMA(1, 1, At, B1); PG8_BAR; PG8_SCHED;
            PG8_LDB(B0, 1, 0); PG8_LDB(B1, 1, 1); PG8_SCHED; PG8_LDA(At, 1, 0); PG8_STAGE(PG8_SA(0, 1), a2 + hstepA, voffA);
            PG8_WAIT_V(8); PG8_WAIT_L(0); PG8_BAR; PG8_MMA(0, 0, At, B0); PG8_MMA(0, 1, At, B1); PG8_BAR; PG8_SCHED;
            PG8_LDA(At, 1, 1); PG8_STAGE(PG8_SB(1, 0), b3, voffB); PG8_STAGE(PG8_SB(1, 1), b3 + hstepB, voffB); PG8_STAGE(PG8_SA(1, 0), a3, voffA);
            PG8_WAIT_V(8); PG8_WAIT_L(0); PG8_BAR; PG8_MMA(1, 0, At, B0); PG8_MMA(1, 1, At, B1); PG8_BAR; PG8_SCHED;
            } else {
            PG8_LDB(B0, 0, 0); PG8_SCHED; PG8_LDA(At, 0, 0); PG8_STAGE(PG8_SA(1, 1), a1 + hstepA, voffA);
            PG8_WAIT_L(8); PG8_BAR; PG8_WAIT_L(0); PG8_MMA(0, 0, At, B0); PG8_BAR; PG8_SCHED;
            PG8_LDB(B1, 0, 1); PG8_STAGE(PG8_SB(0, 0), b2, voffB);
            PG8_BAR; PG8_WAIT_L(0); PG8_MMA(0, 1, At, B1); PG8_BAR;
            PG8_LDA(At, 0, 1); PG8_STAGE(PG8_SA(0, 0), a2, voffA);
            PG8_BAR; PG8_WAIT_L(0); PG8_MMA(1, 0, At, B0); PG8_BAR; PG8_SCHED;
            PG8_STAGE(PG8_SB(0, 1), b2 + hstepB, voffB);
            PG8_WAIT_V(6); PG8_BAR; PG8_MMA(1, 1, At, B1); PG8_BAR;
            PG8_LDB(B0, 1, 0); PG8_SCHED; PG8_LDA(At, 1, 0); PG8_STAGE(PG8_SA(0, 1), a2 + hstepA, voffA);
            PG8_WAIT_L(8); PG8_BAR; PG8_WAIT_L(0); PG8_MMA(0, 0, At, B0); PG8_BAR; PG8_SCHED;
            PG8_LDB(B1, 1, 1); PG8_STAGE(PG8_SB(1, 0), b3, voffB);
            PG8_BAR; PG8_WAIT_L(0); PG8_MMA(0, 1, At, B1); PG8_BAR;
            PG8_LDA(At, 1, 1); PG8_STAGE(PG8_SA(1, 0), a3, voffA);
            PG8_BAR; PG8_WAIT_L(0); PG8_MMA(1, 0, At, B0); PG8_BAR; PG8_SCHED;
            PG8_STAGE(PG8_SB(1, 1), b3 + hstepB, voffB);
            PG8_WAIT_V(6); PG8_BAR; PG8_MMA(1, 1, At, B1); PG8_BAR;
            }
        }
        if constexpr (ALIGN_EPI) { if (wr == 0) PG8_BAR; }
        if constexpr (!Epi::AFTER_DRAIN) { E(acc, cur, wr, wc, fr, fq); S.done(cur); }
        if (!has_next) break;
#pragma unroll
        for (int a = 0; a < 2; ++a)
#pragma unroll
            for (int b = 0; b < 2; ++b)
#pragma unroll
                for (int m = 0; m < 4; ++m)
#pragma unroll
                    for (int n = 0; n < 2; ++n) acc[a][b][m][n] = (f32x4){0.f, 0.f, 0.f, 0.f};
        cur = nxt; cA = nA; cB = nB; ++ui;
        if constexpr (ALIGN_EPI) { if (wr == 1) PG8_BAR; }
    }
    PG8_WAIT_V(0);
    if constexpr (!ALIGN_EPI) { if (wr == 0) PG8_BAR; }
    PG8_BAR;
    if constexpr (Epi::AFTER_DRAIN) { E.fused(acc, cur, wr, wc, fr, fq, lds, wid, lane); S.done(cur); }
#undef PG8_SA
#undef PG8_SB
#undef PG8_STAGE
#undef PG8_LDA
#undef PG8_LDB
#undef PG8_MMA
#undef PG8_WAIT_V
#undef PG8_WAIT_L
#undef PG8_BAR
#undef PG8_SCHED
}
constexpr int SG_PITCH = 144, SG_TILE = 256 * SG_PITCH, SG_LDS = 4 * SG_TILE;
template <class Epi, class Sched>
__device__ __forceinline__ void sgemm_phase(PG8_LAS unsigned char* lds, const Gemm g, const Sched& S, const Epi& E) {
    int tid_ = threadIdx.x; asm volatile("" : "+v"(tid_)); const int tid = tid_, wid = __builtin_amdgcn_readfirstlane(tid >> 6), lane = tid & 63, wr = wid >> 2, wc = wid & 3, fr = lane & 15, fq = lane >> 4;
    const int nt = g.K / BK;
    const int srow = tid >> 3, schunk = tid & 7;
    const unsigned sl = (unsigned)(srow * SG_PITCH + schunk * 16);
    const unsigned aoff = (unsigned)((wr * 64 + fr) * SG_PITCH + fq * 16);
    const int brow = Epi::PERM ? (8 * (fr >> 2) + (fr & 3)) : fr;
    const unsigned boff = (unsigned)((wc * 32 + brow) * SG_PITCH + fq * 16);
    Unit cur;
    for (int ui = 0; S.next(ui, cur); ++ui) {
        f32x4 acc[2][2][4][2];
#pragma unroll
        for (int a = 0; a < 2; ++a)
#pragma unroll
            for (int b = 0; b < 2; ++b)
#pragma unroll
                for (int m = 0; m < 4; ++m)
#pragma unroll
                    for (int n = 0; n < 2; ++n) acc[a][b][m][n] = (f32x4){0.f, 0.f, 0.f, 0.f};
        const bf16_t* gA = g.A + (size_t)(cur.pm * BM + srow) * g.lda + schunk * 8;
        const bf16_t* gB = g.Bt + (size_t)(cur.pn * BM + srow) * g.ldb + schunk * 8;
        u32x4 ra[4], rb[4];
#pragma unroll
        for (int p = 0; p < 4; ++p) { ra[p] = *(const u32x4*)(gA + (size_t)p * 64 * g.lda); rb[p] = *(const u32x4*)(gB + (size_t)p * 64 * g.ldb); }
#pragma unroll
        for (int p = 0; p < 4; ++p) { *(PG8_LAS u32x4*)(lds + sl + p * 64 * SG_PITCH) = ra[p]; *(PG8_LAS u32x4*)(lds + 2 * SG_TILE + sl + p * 64 * SG_PITCH) = rb[p]; }
        __syncthreads();
        for (int t = 0; t < nt; ++t) {
            const int buf = t & 1;
            if constexpr (Epi::MIDK) { if (t == (nt >> 1)) E.mid(acc, cur, wr, wc, fr, fq); }
            if (t + 1 < nt) {
#pragma unroll
                for (int p = 0; p < 4; ++p) { ra[p] = *(const u32x4*)(gA + (size_t)p * 64 * g.lda + (t + 1) * BK); rb[p] = *(const u32x4*)(gB + (size_t)p * 64 * g.ldb + (t + 1) * BK); }
            }
            PG8_LAS unsigned char* la = lds + buf * SG_TILE; PG8_LAS unsigned char* lb = lds + 2 * SG_TILE + buf * SG_TILE;
#pragma unroll
            for (int k = 0; k < 2; ++k) {
                bf16x8 Bf[2][2], Af[2][4];
#pragma unroll
                for (int bj = 0; bj < 2; ++bj)
#pragma unroll
                    for (int n = 0; n < 2; ++n) Bf[bj][n] = *(const PG8_LAS bf16x8*)(lb + boff + (bj * 128 + (Epi::PERM ? 4 * n : 16 * n)) * SG_PITCH + k * 64);
#pragma unroll
                for (int ai = 0; ai < 2; ++ai)
#pragma unroll
                    for (int m = 0; m < 4; ++m) Af[ai][m] = *(const PG8_LAS bf16x8*)(la + aoff + (ai * 128 + m * 16) * SG_PITCH + k * 64);
#pragma unroll
                for (int ai = 0; ai < 2; ++ai)
#pragma unroll
                    for (int bj = 0; bj < 2; ++bj)
#pragma unroll
                        for (int m = 0; m < 4; ++m)
#pragma unroll
                            for (int n = 0; n < 2; ++n) acc[ai][bj][m][n] = __builtin_amdgcn_mfma_f32_16x16x32_bf16(Bf[bj][n], Af[ai][m], acc[ai][bj][m][n], 0, 0, 0);
            }
            if (t + 1 < nt) {
                const int nb = buf ^ 1;
#pragma unroll
                for (int p = 0; p < 4; ++p) { *(PG8_LAS u32x4*)(lds + nb * SG_TILE + sl + p * 64 * SG_PITCH) = ra[p]; *(PG8_LAS u32x4*)(lds + 2 * SG_TILE + nb * SG_TILE + sl + p * 64 * SG_PITCH) = rb[p]; }
            }
            __syncthreads();
        }
        E(acc, cur, wr, wc, fr, fq);
    }
}
}

#define LAS __attribute__((address_space(3)))
typedef unsigned short bf16;
typedef float f32x4 __attribute__((ext_vector_type(4)));
typedef float f32x16 __attribute__((ext_vector_type(16)));
typedef short bf16x8 __attribute__((ext_vector_type(8)));
typedef short s16x4 __attribute__((ext_vector_type(4)));
typedef unsigned u32x4 __attribute__((ext_vector_type(4)));
typedef unsigned u32x2 __attribute__((ext_vector_type(2)));

constexpr int BATCH = 4, SEQ = 8192, DM = 1024, T = BATCH * SEQ, NL = 2, DFF = 2816, NUP = 5632, PROJ = 5128, NPROJ = 5120, NMOD = 6144;
constexpr float LN_EPS = 1e-5f, ALPHA = 1.41421356237309515f, LOG2E = 1.4426950408889634f;
constexpr size_t MiB = 1u << 20;
constexpr size_t WS_MOD = 1 * MiB, WS_LF = 2 * MiB, WS_FL2 = 3 * MiB;
constexpr size_t WS_WIN = 4 * MiB, WS_WBR = 24 * MiB, WS_WOUT = 28 * MiB, WS_WUP = 32 * MiB, WS_WDN = 54 * MiB;
constexpr size_t WS_H = 66 * MiB, WS_QQ = 130 * MiB, WS_K = 194 * MiB, WS_V = 258 * MiB, WS_G = 322 * MiB;
constexpr size_t WS_MIX = 194 * MiB, WS_GFF = 130 * MiB, WS_HD = 322 * MiB, WS_TL = 344 * MiB, WS_Y = 322 * MiB, WS_END = 450 * MiB;
constexpr int LDS_BYTES = 147456 + 1024;
constexpr int NWAVES = 8;

struct Args {
    const float *x, *c, *w_in, *b_f, *rel_bias, *w_br_fox, *w_br_chunk, *w_out, *w_up, *conv_w, *conv_b, *w_down, *w_ada, *b_ada, *ln1_g, *ln1_b, *ln2_g, *ln2_b;
    float* out; unsigned char* ws;
    int phm, pad;
};

__device__ __forceinline__ unsigned f2bf(float f) { unsigned u = __builtin_bit_cast(unsigned, f); return (u + 0x7fffu + ((u >> 16) & 1u)) >> 16; }
__device__ __forceinline__ unsigned pk2(float lo, float hi) { return f2bf(lo) | (f2bf(hi) << 16); }
template <int CTRL> __device__ __forceinline__ float dpp_rot(float v) { return __builtin_bit_cast(float, __builtin_amdgcn_update_dpp(0, __builtin_bit_cast(int, v), CTRL, 0xf, 0xf, false)); }
__device__ __forceinline__ float wave_sum(float v) {
    v += dpp_rot<0x128>(v); v += dpp_rot<0x124>(v); v += dpp_rot<0x122>(v); v += dpp_rot<0x121>(v);
    v += __shfl_xor(v, 16); v += __shfl_xor(v, 32);
    return v;
}

__device__ __forceinline__ int opq_v(int t) { asm volatile("" : "+v"(t)); return t; }
__device__ __forceinline__ int opq_s(int t) { asm volatile("" : "+s"(t)); return t; }

__device__ __forceinline__ void mod_phase(const Args& a, LAS unsigned char* lds, int G) {
    LAS float* condL = (LAS float*)lds;
    LAS float* red = (LAS float*)(lds + 16384);
    const int tid = opq_v((int)threadIdx.x);
    float* mod = (float*)(a.ws + WS_MOD);
    for (int i = tid; i < BATCH * DM; i += 512) { const float c = a.c[i]; condL[i] = c / (1.0f + __expf(-c)); }
    __syncthreads();
    for (int u = blockIdx.x; u < NL * (NMOD / 64); u += G) {
        const int l = u / (NMOD / 64), j0 = (u % (NMOD / 64)) * 64, col = tid & 63, kg = tid >> 6;
        float acc[BATCH] = {0.f, 0.f, 0.f, 0.f};
        const float* wp = a.w_ada + ((size_t)l * DM + kg * 128) * NMOD + j0 + col;
#pragma unroll 8
        for (int k = 0; k < 128; ++k) { const float w = wp[(size_t)k * NMOD];
#pragma unroll
            for (int b = 0; b < BATCH; ++b) acc[b] += condL[b * DM + kg * 128 + k] * w; }
#pragma unroll
        for (int b = 0; b < BATCH; ++b) red[(kg * 4 + b) * 64 + col] = acc[b];
        __syncthreads();
        if (tid < 256) { const int b = tid >> 6; float s = a.b_ada[l * NMOD + j0 + col];
#pragma unroll
            for (int g = 0; g < 8; ++g) s += red[(g * 4 + b) * 64 + col];
            mod[((size_t)l * BATCH + b) * NMOD + j0 + col] = s; }
        __syncthreads();
    }
}

__device__ __forceinline__ void tr_item(const float* W, int Nsrc, int k0, int n0s, bf16* WT, int ldk, int drow0, int koff, LAS float* scr, int lane) {
#pragma unroll 8
    for (int i = 0; i < 32; ++i) { const int kk = 2 * i + (lane >> 5); scr[kk * 33 + (lane & 31)] = W[(size_t)(k0 + kk) * Nsrc + n0s + (lane & 31)]; }
    asm volatile("s_waitcnt lgkmcnt(0)" ::: "memory");
    const int c = lane & 7;
#pragma unroll
    for (int j = 0; j < 4; ++j) { const int n = (lane >> 3) + 8 * j; const LAS float* s = scr + (8 * c) * 33 + n;
        u32x4 o; o.x = pk2(s[0 * 33], s[1 * 33]); o.y = pk2(s[2 * 33], s[3 * 33]); o.z = pk2(s[4 * 33], s[5 * 33]); o.w = pk2(s[6 * 33], s[7 * 33]);
        *(u32x4*)(WT + (size_t)(drow0 + n) * ldk + koff + k0 + 8 * c) = o; }
    asm volatile("s_waitcnt lgkmcnt(0)" ::: "memory");
}
__device__ __forceinline__ void weights_phase(const Args& a, LAS unsigned char* lds, int G) {
    const int tid = opq_v((int)threadIdx.x); const int lane = tid & 63, wave = tid >> 6;
    LAS float* scr = (LAS float*)(lds + 32768 + wave * 8704);
    const int gw = blockIdx.x * NWAVES + wave, NGW = G * NWAVES;
    constexpr int I_IN = 16 * 160, I_BR = 8 * 32, I_OUT = 16 * 32, I_UP = 16 * 176, I_DN = 44 * 32, I_L = I_IN + 2 * I_BR + I_OUT + I_UP + I_DN;
    for (int it = gw; it < NL * I_L; it += NGW) {
        const int l = it / I_L; int r = it % I_L;
        if (r < I_IN) { const int kb = r / 160, nb = r % 160, d = nb * 32, seg = d >> 9;
            const int segsrc = seg == 0 ? 0 : seg == 1 ? 1544 : seg == 2 ? 512 : seg == 3 ? 2056 : seg == 4 ? 1024 : seg == 5 ? 2568 : 3080 + (seg - 6) * 512;
            tr_item(a.w_in + (size_t)l * DM * PROJ, PROJ, kb * 64, segsrc + (d & 511), (bf16*)(a.ws + WS_WIN) + (size_t)l * NPROJ * DM, DM, d, 0, scr, lane); continue; }
        r -= I_IN;
        if (r < I_BR) { const int kb = r / 32, nb = r % 32; tr_item(a.w_br_fox + (size_t)l * 512 * DM, DM, kb * 64, nb * 32, (bf16*)(a.ws + WS_WBR) + (size_t)l * DM * DM, DM, nb * 32, 0, scr, lane); continue; }
        r -= I_BR;
        if (r < I_BR) { const int kb = r / 32, nb = r % 32; tr_item(a.w_br_chunk + (size_t)l * 512 * DM, DM, kb * 64, nb * 32, (bf16*)(a.ws + WS_WBR) + (size_t)l * DM * DM, DM, nb * 32, 512, scr, lane); continue; }
        r -= I_BR;
        if (r < I_OUT) { const int kb = r / 32, nb = r % 32; tr_item(a.w_out + (size_t)l * DM * DM, DM, kb * 64, nb * 32, (bf16*)(a.ws + WS_WOUT) + (size_t)l * DM * DM, DM, nb * 32, 0, scr, lane); continue; }
        r -= I_OUT;
        if (r < I_UP) { const int kb = r / 176, nb = r % 176, d = nb * 32, pn = d >> 8, bj = (d >> 7) & 1, j = d & 127;
            tr_item(a.w_up + (size_t)l * DM * NUP, NUP, kb * 64, bj * DFF + 128 * pn + j, (bf16*)(a.ws + WS_WUP) + (size_t)l * NUP * DM, DM, d, 0, scr, lane); continue; }
        r -= I_UP;
        { const int kb = r / 32, nb = r % 32; tr_item(a.w_down + (size_t)l * DFF * DM, DM, kb * 64, nb * 32, (bf16*)(a.ws + WS_WDN) + (size_t)l * DM * DFF, DFF, nb * 32, 0, scr, lane); }
    }
}

struct V16 { f32x4 v[4]; };
__device__ __forceinline__ V16 ldv(const float* p, int lane) { V16 r;
#pragma unroll
    for (int j = 0; j < 4; ++j) r.v[j] = *(const f32x4*)(p + 256 * j + 4 * lane);
    return r; }
__device__ __forceinline__ void ln_stats(const V16& x, float& mean, float& rstd) {
    float s = 0.f;
#pragma unroll
    for (int j = 0; j < 4; ++j) s += (x.v[j][0] + x.v[j][1]) + (x.v[j][2] + x.v[j][3]);
    mean = wave_sum(s) * (1.f / DM); float q = 0.f;
#pragma unroll
    for (int j = 0; j < 4; ++j) { const f32x4 d = x.v[j] - mean; q += (d[0] * d[0] + d[1] * d[1]) + (d[2] * d[2] + d[3] * d[3]); }
    rstd = 1.f / sqrtf(wave_sum(q) * (1.f / DM) + LN_EPS);
}
template <bool RES, bool HOUT, bool FOUT>
__device__ __forceinline__ void ln_pass(const Args& a, LAS unsigned char* lds, int G, const float* xin, const bf16* add, float* xout,
                                        const float* mod_gate  , const float* lg, const float* lb,
                                        const float* mod_sc, const float* mod_sh, int f_layer) {
    const int tid = opq_v((int)threadIdx.x), lane = tid & 63, wave = tid >> 6;
    LAS float* wfL = (LAS float*)lds;
    if (FOUT) {
        for (int i = tid; i < 2048; i += 512) { const int k = i >> 1, hf = i & 1;
            const f32x4 w = *(const f32x4*)(a.w_in + ((size_t)f_layer * DM + k) * PROJ + 1536 + hf * 4);
#pragma unroll
            for (int e = 0; e < 4; ++e) wfL[(hf * 4 + e) * DM + k] = w[e]; }
        __syncthreads();
    }
    const int gw = blockIdx.x * NWAVES + wave, NGW = G * NWAVES;
    const int rpw = (T + NGW - 1) / NGW; const int r0 = gw * rpw, r1 = (r0 + rpw < T) ? r0 + rpw : T;
    bf16* hout = (bf16*)(a.ws + WS_H); float* lf = (float*)(a.ws + WS_LF);
    V16 xnext; u32x2 ynext[4];
    if (r0 < r1) { xnext = ldv(xin + (size_t)r0 * DM, lane);
        if (RES) {
#pragma unroll
            for (int j = 0; j < 4; ++j) ynext[j] = *(const u32x2*)(add + (size_t)r0 * DM + 256 * j + 4 * lane); } }
    for (int row = r0; row < r1; ++row) {
        const int b = row / SEQ;
        const float *pg = mod_gate, *plg = lg, *plb = lb, *psc = mod_sc, *psh = mod_sh;
        asm volatile("" : "+s"(pg), "+s"(plg), "+s"(plb), "+s"(psc), "+s"(psh));
        V16 x = xnext; float mean, rstd; u32x2 ycur[4];
        if (RES) {
#pragma unroll
            for (int j = 0; j < 4; ++j) ycur[j] = ynext[j]; }
        if (row + 1 < r1) { xnext = ldv(xin + (size_t)(row + 1) * DM, lane);
            if (RES) {
#pragma unroll
                for (int j = 0; j < 4; ++j) ynext[j] = *(const u32x2*)(add + (size_t)(row + 1) * DM + 256 * j + 4 * lane); } }
        if (RES) { { V16 y;
#pragma unroll
            for (int j = 0; j < 4; ++j) { const u32x2 w = ycur[j]; y.v[j][0] = __uint_as_float(w.x << 16); y.v[j][1] = __uint_as_float(w.x & 0xffff0000u); y.v[j][2] = __uint_as_float(w.y << 16); y.v[j][3] = __uint_as_float(w.y & 0xffff0000u); }
            const V16 vg = ldv(pg + (size_t)b * NMOD, lane);
#pragma unroll
            for (int j = 0; j < 4; ++j) x.v[j] = ALPHA * x.v[j] + (1.0f + vg.v[j]) * y.v[j]; }
            ln_stats(x, mean, rstd);
            { const V16 vlg = ldv(plg, lane), vlb = ldv(plb, lane);
#pragma unroll
            for (int j = 0; j < 4; ++j) { x.v[j] = (x.v[j] - mean) * rstd * vlg.v[j] + vlb.v[j]; *(f32x4*)(xout + (size_t)row * DM + 256 * j + 4 * lane) = x.v[j]; } } }
        if (HOUT) {
            ln_stats(x, mean, rstd);
            { const V16 vsc = ldv(psc + (size_t)b * NMOD, lane), vsh = ldv(psh + (size_t)b * NMOD, lane);
#pragma unroll
            for (int j = 0; j < 4; ++j) { x.v[j] = (x.v[j] - mean) * rstd * (1.0f + vsc.v[j]) + vsh.v[j];
                u32x2 w; w.x = pk2(x.v[j][0], x.v[j][1]); w.y = pk2(x.v[j][2], x.v[j][3]); *(u32x2*)(hout + (size_t)row * DM + 256 * j + 4 * lane) = w; } }
            if (FOUT) { float myf = 0.f;
#pragma unroll 2
                for (int hh = 0; hh < 8; ++hh) { float s = 0.f;
#pragma unroll
                    for (int j = 0; j < 4; ++j) { const f32x4 w = *(const LAS f32x4*)(wfL + hh * DM + 256 * j + 4 * lane); s += (x.v[j][0] * w[0] + x.v[j][1] * w[1]) + (x.v[j][2] * w[2] + x.v[j][3] * w[3]); }
                    s = wave_sum(s); if (lane == hh) myf = s; }
                if (lane < 8) { const float z = myf + a.b_f[f_layer * 8 + lane];
                    const float ez = __expf(-fabsf(z)); const float l1p = (ez < 1e-4f) ? ez * (1.0f - 0.5f * ez) : __logf(1.0f + ez);
                    const float ls = fminf(z, 0.f) - l1p;
                    lf[(size_t)row * 8 + lane] = ls; } }
        }
    }
}

__device__ __forceinline__ void scan_phase(const Args& a, LAS unsigned char* lds, int G) {
    const int tid = opq_v((int)threadIdx.x), lane = tid & 63, wave = tid >> 6;
    LAS double* ws = (LAS double*)lds;
    const float* lf = (const float*)(a.ws + WS_LF); float* fl2 = (float*)(a.ws + WS_FL2);
    for (int sq = blockIdx.x; sq < BATCH * 8; sq += G) {
        const int b = sq >> 3, hh = sq & 7;
        float v[16]; double s = 0.0;
#pragma unroll
        for (int i = 0; i < 16; ++i) { v[i] = lf[((size_t)b * SEQ + tid * 16 + i) * 8 + hh]; s += (double)v[i]; }
        double inc = s;
#pragma unroll
        for (int o = 1; o < 64; o <<= 1) { const double n = __shfl_up(inc, o); if (lane >= o) inc += n; }
        if (lane == 63) ws[wave] = inc;
        __syncthreads();
        double base = inc - s;
        for (int w = 0; w < wave; ++w) base += ws[w];
        double run = base;
#pragma unroll
        for (int i = 0; i < 16; ++i) { run += (double)v[i]; fl2[((size_t)b * 8 + hh) * SEQ + tid * 16 + i] = (float)(run * (double)LOG2E); }
        __syncthreads();
    }
}

__device__ __forceinline__ int crow(int r, int hi) { return (r & 3) + 8 * (r >> 2) + 4 * hi; }
constexpr int VT_STRIDE = 136, AL_K = 0, AL_VT = 16384, VT2_STRIDE = 144, VT2BUF = 64 * 144, AL_FB = 16384 + 2 * VT2BUF, AL_EXT = AL_FB + 512, AL_MISC = AL_EXT + 2560;
constexpr size_t WS_KN = 800 * 1024;
template <int MODE>
__device__ __forceinline__ void attn_unit(const bf16* QQ, const bf16* KK, const bf16* VV, bf16* OO, const float* fl2, const float* relb, int b, int h, int qb, LAS unsigned char* lds, float kmax2 = 0.f) {
    const int tid = opq_v((int)threadIdx.x), lane = tid & 63, r32 = lane & 31, hi = lane >> 5, wid = __builtin_amdgcn_readfirstlane(tid >> 6);
    const int hc = (MODE == 0 ? 0 : 512) + h * 64;
    const size_t rowbase = (size_t)b * SEQ; const int q0 = qb * 256;
    int kc0, NT;
    if (MODE == 0) { kc0 = 0; NT = 4 * (qb + 1); } else { kc0 = 4 * qb - 8 < 0 ? 0 : 4 * qb - 8; NT = 4 * qb + 4 - kc0; }
    if (MODE == 0) {
        float qn = 0.f;
        { const bf16* Qn = QQ + (rowbase + q0 + (tid >> 1)) * DM + hc + (tid & 1) * 32;
#pragma unroll
          for (int c = 0; c < 4; ++c) { const u32x4 v = *(const u32x4*)(Qn + c * 8);
              { const float lo = __uint_as_float(v.x << 16), hh = __uint_as_float(v.x & 0xffff0000u); qn += lo * lo + hh * hh; }
              { const float lo = __uint_as_float(v.y << 16), hh = __uint_as_float(v.y & 0xffff0000u); qn += lo * lo + hh * hh; }
              { const float lo = __uint_as_float(v.z << 16), hh = __uint_as_float(v.z & 0xffff0000u); qn += lo * lo + hh * hh; }
              { const float lo = __uint_as_float(v.w << 16), hh = __uint_as_float(v.w & 0xffff0000u); qn += lo * lo + hh * hh; } } }
        qn += __shfl_xor(qn, 1);
#pragma unroll
        for (int o = 32; o >= 2; o >>= 1) qn = fmaxf(qn, __shfl_xor(qn, o));
        LAS float* red = (LAS float*)(lds + AL_MISC); LAS int* t0s = (LAS int*)(lds + AL_MISC + 64);
        if (lane == 0) red[wid] = qn;
        if (tid == 0) *t0s = 4 * qb;
        __syncthreads();
        float q2 = red[0];
#pragma unroll
        for (int w = 1; w < 8; ++w) q2 = fmaxf(q2, red[w]);
        const float thr = 152.0f + 2.002f * sqrtf(q2 * kmax2);
        const float* fl = fl2 + ((size_t)b * 8 + h) * SEQ; const float fq0 = fl[q0];
        if (tid < 4 * qb) { if (fl[64 * tid + 63] - fq0 <= thr) atomicMin((int*)t0s, tid); }
        __syncthreads();
        kc0 = __builtin_amdgcn_readfirstlane(*t0s); NT = 4 * (qb + 1) - kc0;
    }
    const bf16* Qw = QQ + (rowbase + q0 + wid * 32 + r32) * DM + hc;
    bf16x8 qr[4];
#pragma unroll
    for (int d0 = 0; d0 < 4; ++d0) qr[d0] = *(const bf16x8*)(Qw + d0 * 16 + hi * 8);
    const int myc = 4 * qb + (wid >> 1);
    if (MODE == 1) {
        LAS float* rev = (LAS float*)(lds + AL_EXT);
        for (int i = tid; i < 639; i += 512) { int d = 575 - i; d = d > 128 ? 128 : d; rev[i] = LOG2E * relb[h * 257 + d + 128]; }
    }
    const int kvr = tid & 63, ch = tid >> 6;
    const bf16* gK = KK + (rowbase + (size_t)kc0 * 64 + kvr) * DM + hc + ch * 8;
    const bf16* gV = VV + (rowbase + (size_t)kc0 * 64 + kvr) * DM + hc + ch * 8;
    const float* gF = fl2 + ((size_t)b * 8 + h) * SEQ + kc0 * 64 + (tid & 63);
    u32x4 kreg = *(const u32x4*)gK, vreg = *(const u32x4*)gV; float freg = 0.f;
    if (MODE == 0 && tid < 64) freg = *gF;
    float m_run = -1e30f, l_run = 0.f; f32x16 ot0 = {}, ot1 = {};
    const int qabs = q0 + wid * 32 + r32;
    for (int t = 0; t < NT; ++t) {
        const int buf = t & 1;
        {
            *(LAS u32x4*)(lds + AL_K + buf * 8192 + (ch * 64 + kvr) * 16) = kreg;
            LAS unsigned short* vt = (LAS unsigned short*)(lds + AL_VT + buf * 8704) + (ch * 8) * (VT_STRIDE / 2) + kvr;
            vt[0 * 68] = (unsigned short)(vreg.x & 0xffff); vt[1 * 68] = (unsigned short)(vreg.x >> 16);
            vt[2 * 68] = (unsigned short)(vreg.y & 0xffff); vt[3 * 68] = (unsigned short)(vreg.y >> 16);
            vt[4 * 68] = (unsigned short)(vreg.z & 0xffff); vt[5 * 68] = (unsigned short)(vreg.z >> 16);
            vt[6 * 68] = (unsigned short)(vreg.w & 0xffff); vt[7 * 68] = (unsigned short)(vreg.w >> 16);
            if (MODE == 0 && tid < 64) *(LAS float*)(lds + AL_FB + buf * 256 + tid * 4) = freg;
        }
        __syncthreads();
        if (t + 1 < NT) { kreg = *(const u32x4*)(gK + (size_t)(t + 1) * 64 * DM); vreg = *(const u32x4*)(gV + (size_t)(t + 1) * 64 * DM); if (MODE == 0 && tid < 64) freg = gF[(t + 1) * 64]; }
        const int kv0 = (kc0 + t) * 64;
        bool part;
        if (MODE == 0) part = kv0 <= q0 + wid * 32 + 31; else { const int kc = kc0 + t; part = (kc <= myc) && (kc >= myc - 8); }
        if (part) {
            f32x16 p0 = {}, p1 = {};
            const LAS unsigned char* kbp = lds + AL_K + buf * 8192 + hi * 1024 + r32 * 16;
#pragma unroll
            for (int d0 = 0; d0 < 4; ++d0) {
                const bf16x8 a0 = *(const LAS bf16x8*)(kbp + d0 * 2048), a1 = *(const LAS bf16x8*)(kbp + d0 * 2048 + 512);
                p0 = __builtin_amdgcn_mfma_f32_32x32x16_bf16(a0, qr[d0], p0, 0, 0, 0);
                p1 = __builtin_amdgcn_mfma_f32_32x32x16_bf16(a1, qr[d0], p1, 0, 0, 0);
            }
            if (MODE == 0) {
                const LAS float* fb = (const LAS float*)(lds + AL_FB + buf * 256);
#pragma unroll
                for (int g = 0; g < 4; ++g) { const f32x4 f0 = *(const LAS f32x4*)(fb + 8 * g + 4 * hi), f1 = *(const LAS f32x4*)(fb + 32 + 8 * g + 4 * hi);
#pragma unroll
                    for (int e = 0; e < 4; ++e) { p0[4 * g + e] -= f0[e]; p1[4 * g + e] -= f1[e]; } }
                if (kv0 + 63 > q0 + wid * 32) {
#pragma unroll
                    for (int r = 0; r < 16; ++r) { const int kv = kv0 + crow(r, hi); if (kv > qabs) p0[r] = -1e30f; if (kv + 32 > qabs) p1[r] = -1e30f; }
                }
            } else {
                const LAS float* rv = (const LAS float*)(lds + AL_EXT) + (575 - (qabs - kv0) + 4 * hi);
#pragma unroll
                for (int r = 0; r < 16; ++r) { const int C = (r & 3) + 8 * (r >> 2); p0[r] += rv[C]; p1[r] += rv[C + 32]; }
            }
            float mx = p0[0];
#pragma unroll
            for (int r = 1; r < 16; ++r) mx = fmaxf(mx, p0[r]);
#pragma unroll
            for (int r = 0; r < 16; ++r) mx = fmaxf(mx, p1[r]);
            { const auto rr = __builtin_amdgcn_permlane32_swap(__float_as_uint(mx), __float_as_uint(mx), false, false); mx = fmaxf(__uint_as_float(rr[0]), __uint_as_float(rr[1])); }
            const float mnew = fmaxf(m_run, mx), sc = __builtin_amdgcn_exp2f(m_run - mnew); m_run = mnew;
            float rs = 0.f;
#pragma unroll
            for (int r = 0; r < 16; ++r) { p0[r] = __builtin_amdgcn_exp2f(p0[r] - mnew); p1[r] = __builtin_amdgcn_exp2f(p1[r] - mnew); rs += p0[r] + p1[r]; }
            l_run = l_run * sc + rs;
#pragma unroll
            for (int r = 0; r < 16; ++r) { ot0[r] *= sc; ot1[r] *= sc; }
            bf16x8 pa[4];
#pragma unroll
            for (int s = 0; s < 4; ++s) { u32x4 w;
                if (s < 2) { w.x = pg8::cvt_pk_bf16(p0[8 * s + 0], p0[8 * s + 1]); w.y = pg8::cvt_pk_bf16(p0[8 * s + 2], p0[8 * s + 3]); w.z = pg8::cvt_pk_bf16(p0[8 * s + 4], p0[8 * s + 5]); w.w = pg8::cvt_pk_bf16(p0[8 * s + 6], p0[8 * s + 7]); }
                else { const int q = 8 * (s - 2); w.x = pg8::cvt_pk_bf16(p1[q + 0], p1[q + 1]); w.y = pg8::cvt_pk_bf16(p1[q + 2], p1[q + 3]); w.z = pg8::cvt_pk_bf16(p1[q + 4], p1[q + 5]); w.w = pg8::cvt_pk_bf16(p1[q + 6], p1[q + 7]); }
                pa[s] = __builtin_bit_cast(bf16x8, w); }
            const LAS unsigned char* vtb = lds + AL_VT + buf * 8704 + r32 * VT_STRIDE + hi * 8;
#pragma unroll
            for (int s = 0; s < 4; ++s) {
                const u32x2 a_lo = *(const LAS u32x2*)(vtb + s * 32), a_hi = *(const LAS u32x2*)(vtb + s * 32 + 16);
                const u32x2 b_lo = *(const LAS u32x2*)(vtb + 32 * VT_STRIDE + s * 32), b_hi = *(const LAS u32x2*)(vtb + 32 * VT_STRIDE + s * 32 + 16);
                const bf16x8 va = __builtin_bit_cast(bf16x8, (u32x4){a_lo.x, a_lo.y, a_hi.x, a_hi.y}), vb = __builtin_bit_cast(bf16x8, (u32x4){b_lo.x, b_lo.y, b_hi.x, b_hi.y});
                ot0 = __builtin_amdgcn_mfma_f32_32x32x16_bf16(va, pa[s], ot0, 0, 0, 0);
                ot1 = __builtin_amdgcn_mfma_f32_32x32x16_bf16(vb, pa[s], ot1, 0, 0, 0);
            }
        }
    }
    l_run += __shfl_xor(l_run, 32);
    const float inv = 1.0f / l_run;
    bf16* Ow = OO + (rowbase + q0 + wid * 32 + r32) * DM + hc;
#pragma unroll
    for (int g = 0; g < 4; ++g) {
        u32x2 w0, w1;
        w0.x = pg8::cvt_pk_bf16(ot0[4 * g + 0] * inv, ot0[4 * g + 1] * inv); w0.y = pg8::cvt_pk_bf16(ot0[4 * g + 2] * inv, ot0[4 * g + 3] * inv);
        w1.x = pg8::cvt_pk_bf16(ot1[4 * g + 0] * inv, ot1[4 * g + 1] * inv); w1.y = pg8::cvt_pk_bf16(ot1[4 * g + 2] * inv, ot1[4 * g + 3] * inv);
        *(u32x2*)(Ow + 8 * g + 4 * hi) = w0; *(u32x2*)(Ow + 32 + 8 * g + 4 * hi) = w1;
    }
    __syncthreads();
}


#define SOFTMAX_GROUP(P0, P1, MRUN, LRUN, OT0, OT1, PA) do { \
            float mx = P0[0]; \
            _Pragma("unroll") for (int r = 1; r < 16; ++r) mx = fmaxf(mx, P0[r]); \
            _Pragma("unroll") for (int r = 0; r < 16; ++r) mx = fmaxf(mx, P1[r]); \
            { const auto rr = __builtin_amdgcn_permlane32_swap(__float_as_uint(mx), __float_as_uint(mx), false, false); mx = fmaxf(__uint_as_float(rr[0]), __uint_as_float(rr[1])); } \
            const float mnew = fmaxf(MRUN, mx), sc = __builtin_amdgcn_exp2f(MRUN - mnew); MRUN = mnew; \
            float rs = 0.f; \
            _Pragma("unroll") for (int r = 0; r < 16; ++r) { P0[r] = __builtin_amdgcn_exp2f(P0[r] - mnew); P1[r] = __builtin_amdgcn_exp2f(P1[r] - mnew); rs += P0[r] + P1[r]; } \
            LRUN = LRUN * sc + rs; \
            _Pragma("unroll") for (int r = 0; r < 16; ++r) { OT0[r] *= sc; OT1[r] *= sc; } \
            _Pragma("unroll") for (int s = 0; s < 4; ++s) { u32x4 w; \
                if (s < 2) { w.x = pg8::cvt_pk_bf16(P0[8 * s + 0], P0[8 * s + 1]); w.y = pg8::cvt_pk_bf16(P0[8 * s + 2], P0[8 * s + 3]); w.z = pg8::cvt_pk_bf16(P0[8 * s + 4], P0[8 * s + 5]); w.w = pg8::cvt_pk_bf16(P0[8 * s + 6], P0[8 * s + 7]); } \
                else { const int q = 8 * (s - 2); w.x = pg8::cvt_pk_bf16(P1[q + 0], P1[q + 1]); w.y = pg8::cvt_pk_bf16(P1[q + 2], P1[q + 3]); w.z = pg8::cvt_pk_bf16(P1[q + 4], P1[q + 5]); w.w = pg8::cvt_pk_bf16(P1[q + 6], P1[q + 7]); } \
                PA[s] = __builtin_bit_cast(bf16x8, w); } \
        } while (0)
template <int MODE>
__device__ __forceinline__ void attn_unit2(const bf16* QQ, const bf16* KK, const bf16* VV, bf16* OO, const float* fl2, const float* relb, int b, int h, int qb, LAS unsigned char* lds, float kmax2 = 0.f) {
    const int tid = opq_v((int)threadIdx.x), lane = tid & 63, r32 = lane & 31, hi = lane >> 5, wid = __builtin_amdgcn_readfirstlane(tid >> 6);
    const int hc = (MODE == 0 ? 0 : 512) + h * 64;
    const size_t rowbase = (size_t)b * SEQ; const int q0 = qb * 512;
    int kc0, NT;
    if (MODE == 0) { kc0 = 0; NT = 8 * (qb + 1); } else { kc0 = 8 * qb - 8 < 0 ? 0 : 8 * qb - 8; NT = 8 * qb + 8 - kc0; }
    if (MODE == 0) {
        float qn = 0.f;
        { const bf16* Qn = QQ + (rowbase + q0 + tid) * DM + hc;
#pragma unroll
          for (int c = 0; c < 8; ++c) { const u32x4 v = *(const u32x4*)(Qn + c * 8);
              { const float lo = __uint_as_float(v.x << 16), hh = __uint_as_float(v.x & 0xffff0000u); qn += lo * lo + hh * hh; }
              { const float lo = __uint_as_float(v.y << 16), hh = __uint_as_float(v.y & 0xffff0000u); qn += lo * lo + hh * hh; }
              { const float lo = __uint_as_float(v.z << 16), hh = __uint_as_float(v.z & 0xffff0000u); qn += lo * lo + hh * hh; }
              { const float lo = __uint_as_float(v.w << 16), hh = __uint_as_float(v.w & 0xffff0000u); qn += lo * lo + hh * hh; } } }
#pragma unroll
        for (int o = 32; o >= 1; o >>= 1) qn = fmaxf(qn, __shfl_xor(qn, o));
        LAS float* red = (LAS float*)(lds + AL_MISC); LAS int* t0s = (LAS int*)(lds + AL_MISC + 64);
        if (lane == 0) red[wid] = qn;
        if (tid == 0) *t0s = 8 * qb;
        __syncthreads();
        float q2 = red[0];
#pragma unroll
        for (int w = 1; w < 8; ++w) q2 = fmaxf(q2, red[w]);
        const float thr = 152.0f + 2.002f * sqrtf(q2 * kmax2);
        const float* fl = fl2 + ((size_t)b * 8 + h) * SEQ; const float fq0 = fl[q0];
        if (tid < 8 * qb) { if (fl[64 * tid + 63] - fq0 <= thr) atomicMin((int*)t0s, tid); }
        __syncthreads();
        kc0 = __builtin_amdgcn_readfirstlane(*t0s); NT = 8 * (qb + 1) - kc0;
    }
    const bf16* QwA = QQ + (rowbase + q0 + wid * 64 + r32) * DM + hc; const bf16* QwB = QwA + (size_t)32 * DM;
    bf16x8 qrA[4], qrB[4];
#pragma unroll
    for (int d0 = 0; d0 < 4; ++d0) { qrA[d0] = *(const bf16x8*)(QwA + d0 * 16 + hi * 8); qrB[d0] = *(const bf16x8*)(QwB + d0 * 16 + hi * 8); }
    const int myc = 8 * qb + wid;
    if (MODE == 1) {
        LAS float* rev = (LAS float*)(lds + AL_EXT);
        for (int i = tid; i < 639; i += 512) { int d = 575 - i; d = d > 128 ? 128 : d; rev[i] = LOG2E * relb[h * 257 + d + 128]; }
    }
    const int kvr = tid & 63, ch = tid >> 6;
    const bf16* gK = KK + (rowbase + (size_t)kc0 * 64 + kvr) * DM + hc + ch * 8;
    const bf16* gV = VV + (rowbase + (size_t)kc0 * 64 + kvr) * DM + hc + ch * 8;
    const float* gF = fl2 + ((size_t)b * 8 + h) * SEQ + kc0 * 64 + (tid & 63);
    u32x4 kreg = *(const u32x4*)gK, vreg = *(const u32x4*)gV; float freg = 0.f;
    if (MODE == 0 && tid < 64) freg = *gF;
    float mA = -1e30f, lA = 0.f, mB = -1e30f, lB = 0.f; f32x16 ot0A = {}, ot1A = {}, ot0B = {}, ot1B = {};
    const int qabsA = q0 + wid * 64 + r32, qabsB = qabsA + 32;
    for (int t = 0; t < NT; ++t) {
        const int buf = t & 1;
        {
            *(LAS u32x4*)(lds + AL_K + buf * 8192 + (ch * 64 + kvr) * 16) = kreg;
            const int pcol = (kvr & ~15) | (kvr & 3) | (((kvr >> 3) & 1) << 2) | (((kvr >> 2) & 1) << 3);
            LAS unsigned short* vt = (LAS unsigned short*)(lds + AL_VT + buf * VT2BUF) + (ch * 8) * (VT2_STRIDE / 2) + pcol;
            vt[0 * 72] = (unsigned short)(vreg.x & 0xffff); vt[1 * 72] = (unsigned short)(vreg.x >> 16);
            vt[2 * 72] = (unsigned short)(vreg.y & 0xffff); vt[3 * 72] = (unsigned short)(vreg.y >> 16);
            vt[4 * 72] = (unsigned short)(vreg.z & 0xffff); vt[5 * 72] = (unsigned short)(vreg.z >> 16);
            vt[6 * 72] = (unsigned short)(vreg.w & 0xffff); vt[7 * 72] = (unsigned short)(vreg.w >> 16);
            if (MODE == 0 && tid < 64) *(LAS float*)(lds + AL_FB + buf * 256 + tid * 4) = freg;
        }
        __syncthreads();
        if (t + 1 < NT) { kreg = *(const u32x4*)(gK + (size_t)(t + 1) * 64 * DM); vreg = *(const u32x4*)(gV + (size_t)(t + 1) * 64 * DM); if (MODE == 0 && tid < 64) freg = gF[(t + 1) * 64]; }
        const int kv0 = (kc0 + t) * 64;
        bool part;
        if (MODE == 0) part = kv0 <= q0 + wid * 64 + 63; else { const int kc = kc0 + t; part = (kc <= myc) && (kc >= myc - 8); }
        if (part) {
            f32x16 p0A = {}, p1A = {}, p0B = {}, p1B = {};
            const LAS unsigned char* kbp = lds + AL_K + buf * 8192 + hi * 1024 + r32 * 16;
#pragma unroll
            for (int d0 = 0; d0 < 4; ++d0) {
                const bf16x8 a0 = *(const LAS bf16x8*)(kbp + d0 * 2048), a1 = *(const LAS bf16x8*)(kbp + d0 * 2048 + 512);
                p0A = __builtin_amdgcn_mfma_f32_32x32x16_bf16(a0, qrA[d0], p0A, 0, 0, 0);
                p1A = __builtin_amdgcn_mfma_f32_32x32x16_bf16(a1, qrA[d0], p1A, 0, 0, 0);
                p0B = __builtin_amdgcn_mfma_f32_32x32x16_bf16(a0, qrB[d0], p0B, 0, 0, 0);
                p1B = __builtin_amdgcn_mfma_f32_32x32x16_bf16(a1, qrB[d0], p1B, 0, 0, 0);
            }
            if (MODE == 0) {
                const LAS float* fb = (const LAS float*)(lds + AL_FB + buf * 256);
#pragma unroll
                for (int g = 0; g < 4; ++g) { const f32x4 f0 = *(const LAS f32x4*)(fb + 8 * g + 4 * hi), f1 = *(const LAS f32x4*)(fb + 32 + 8 * g + 4 * hi);
#pragma unroll
                    for (int e = 0; e < 4; ++e) { p0A[4 * g + e] -= f0[e]; p1A[4 * g + e] -= f1[e]; p0B[4 * g + e] -= f0[e]; p1B[4 * g + e] -= f1[e]; } }
                if (kv0 + 63 > q0 + wid * 64) {
#pragma unroll
                    for (int r = 0; r < 16; ++r) { const int kv = kv0 + crow(r, hi); if (kv > qabsA) p0A[r] = -1e30f; if (kv + 32 > qabsA) p1A[r] = -1e30f; if (kv > qabsB) p0B[r] = -1e30f; if (kv + 32 > qabsB) p1B[r] = -1e30f; }
                }
            } else {
                const LAS float* rvA = (const LAS float*)(lds + AL_EXT) + (575 - (qabsA - kv0) + 4 * hi); const LAS float* rvB = rvA - 32;
#pragma unroll
                for (int r = 0; r < 16; ++r) { const int C = (r & 3) + 8 * (r >> 2); p0A[r] += rvA[C]; p1A[r] += rvA[C + 32]; p0B[r] += rvB[C]; p1B[r] += rvB[C + 32]; }
            }
            bf16x8 paA[4], paB[4];
            SOFTMAX_GROUP(p0A, p1A, mA, lA, ot0A, ot1A, paA);
            SOFTMAX_GROUP(p0B, p1B, mB, lB, ot0B, ot1B, paB);
            const LAS unsigned char* vtb = lds + AL_VT + buf * VT2BUF + r32 * VT2_STRIDE + hi * 16;
#pragma unroll
            for (int s = 0; s < 4; ++s) {
                const bf16x8 va = *(const LAS bf16x8*)(vtb + s * 32), vb = *(const LAS bf16x8*)(vtb + 32 * VT2_STRIDE + s * 32);
                ot0A = __builtin_amdgcn_mfma_f32_32x32x16_bf16(va, paA[s], ot0A, 0, 0, 0);
                ot1A = __builtin_amdgcn_mfma_f32_32x32x16_bf16(vb, paA[s], ot1A, 0, 0, 0);
                ot0B = __builtin_amdgcn_mfma_f32_32x32x16_bf16(va, paB[s], ot0B, 0, 0, 0);
                ot1B = __builtin_amdgcn_mfma_f32_32x32x16_bf16(vb, paB[s], ot1B, 0, 0, 0);
            }
        }
    }
#define STORE_GROUP(LRUN, OT0, OT1, QROW) do { \
        float lt = LRUN; lt += __shfl_xor(lt, 32); const float inv = 1.0f / lt; \
        bf16* Ow = OO + (rowbase + (QROW)) * DM + hc; \
        _Pragma("unroll") for (int g = 0; g < 4; ++g) { u32x2 w0, w1; \
            w0.x = pg8::cvt_pk_bf16(OT0[4 * g + 0] * inv, OT0[4 * g + 1] * inv); w0.y = pg8::cvt_pk_bf16(OT0[4 * g + 2] * inv, OT0[4 * g + 3] * inv); \
            w1.x = pg8::cvt_pk_bf16(OT1[4 * g + 0] * inv, OT1[4 * g + 1] * inv); w1.y = pg8::cvt_pk_bf16(OT1[4 * g + 2] * inv, OT1[4 * g + 3] * inv); \
            *(u32x2*)(Ow + 8 * g + 4 * hi) = w0; *(u32x2*)(Ow + 32 + 8 * g + 4 * hi) = w1; } } while (0)
    STORE_GROUP(lA, ot0A, ot1A, qabsA);
    STORE_GROUP(lB, ot0B, ot1B, qabsB);
#undef STORE_GROUP
    __syncthreads();
}
#undef SOFTMAX_GROUP

__device__ __forceinline__ void knorm_phase(const Args& a, LAS unsigned char* lds, int G, int layer) {
    const int tid = opq_v((int)threadIdx.x), lane = tid & 63, wave = tid >> 6;
    const bf16* KK = (const bf16*)(a.ws + WS_K); unsigned* KN = (unsigned*)(a.ws + WS_KN) + layer * 32;
    LAS float* red = (LAS float*)(lds + AL_MISC);
    for (int item = blockIdx.x; item < 256; item += G) {
        const int bh = item >> 3, part = item & 7;
        const bf16* Kp = KK + ((size_t)(bh >> 3) * SEQ + part * 1024 + wave * 128 + (lane >> 3)) * DM + (bh & 7) * 64 + (lane & 7) * 8;
        float mx = 0.f;
#pragma unroll 4
        for (int it = 0; it < 16; ++it) { const u32x4 v = *(const u32x4*)(Kp + (size_t)it * 8 * DM);
            float s2 = 0.f;
            { const float lo = __uint_as_float(v.x << 16), hi = __uint_as_float(v.x & 0xffff0000u); s2 += lo * lo + hi * hi; }
            { const float lo = __uint_as_float(v.y << 16), hi = __uint_as_float(v.y & 0xffff0000u); s2 += lo * lo + hi * hi; }
            { const float lo = __uint_as_float(v.z << 16), hi = __uint_as_float(v.z & 0xffff0000u); s2 += lo * lo + hi * hi; }
            { const float lo = __uint_as_float(v.w << 16), hi = __uint_as_float(v.w & 0xffff0000u); s2 += lo * lo + hi * hi; }
            s2 += __shfl_xor(s2, 1); s2 += __shfl_xor(s2, 2); s2 += __shfl_xor(s2, 4);
            mx = fmaxf(mx, s2); }
        mx = fmaxf(mx, __shfl_xor(mx, 8)); mx = fmaxf(mx, __shfl_xor(mx, 16)); mx = fmaxf(mx, __shfl_xor(mx, 32));
        if (lane == 0) red[wave] = mx;
        __syncthreads();
        if (tid == 0) { float m = red[0];
#pragma unroll
            for (int w = 1; w < 8; ++w) m = fmaxf(m, red[w]);
            atomicMax(KN + bh, __float_as_uint(m)); }
        __syncthreads();
    }
}
__device__ __forceinline__ void attn_phase(const Args& a, LAS unsigned char* lds, int G, int layer) {
    const bf16* QQ = (const bf16*)(a.ws + WS_QQ); const bf16* KK = (const bf16*)(a.ws + WS_K); const bf16* VV = (const bf16*)(a.ws + WS_V); bf16* OO = (bf16*)(a.ws + WS_QQ);
    const float* fl2 = (const float*)(a.ws + WS_FL2); const float* relb = a.rel_bias + (size_t)layer * 8 * 257;
    {
        unsigned* ctr = (unsigned*)(a.ws + WS_KN) + 64 + layer; const unsigned* KN = (const unsigned*)(a.ws + WS_KN) + layer * 32;
        LAS int* qs = (LAS int*)(lds + AL_MISC + 128);
        for (;;) {
            if (threadIdx.x == 0) *qs = (int)atomicAdd(ctr, 1u);
            __syncthreads();
            const int u = __builtin_amdgcn_readfirstlane(*qs);
            __syncthreads();
            if (u >= 1024) break;
            if (u < 512) { const int bh = u & 31, qb = 15 - (u >> 5);
                attn_unit2<0>(QQ, KK, VV, OO, fl2, relb, bh >> 3, bh & 7, qb, lds, __uint_as_float(KN[bh])); }
            else { const int i = u - 512;
                attn_unit2<1>(QQ, KK, VV, OO, fl2, relb, (i >> 4) >> 3, (i >> 4) & 7, i & 15, lds); }
        }
    }
}

__device__ __forceinline__ void fixup_phase(const Args& a, int G, int layer) {
    const float* HD = (const float*)(a.ws + WS_HD); const float* TL = (const float*)(a.ws + WS_TL); bf16* GF = (bf16*)(a.ws + WS_GFF);
    const float* cw = a.conv_w + (size_t)layer * 3 * NUP; const float* cb = a.conv_b + (size_t)layer * NUP;
    const int total = (T / 64) * 2 * (DFF / 4);
    for (int idx = opq_s((int)blockIdx.x) * 512 + opq_v((int)threadIdx.x); idx < total; idx += G * 512) {
        const int grp = idx / (2 * (DFF / 4)), rem = idx % (2 * (DFF / 4)), e = rem / (DFF / 4), c = (rem % (DFF / 4)) * 4;
        const bool first = (grp % (SEQ / 64)) == 0;
        const f32x4 z = (f32x4){0.f, 0.f, 0.f, 0.f};
        f32x4 u0a, u0v, u1a, u1v, u2a, u2v;
        const float* h0 = HD + (size_t)(grp * 2 + e) * NUP + c; u0a = *(const f32x4*)h0; u0v = *(const f32x4*)(h0 + DFF);
        if (e == 0) {
            if (first) { u1a = z; u1v = z; u2a = z; u2v = z; }
            else { const float* t1 = TL + (size_t)((grp - 1) * 2 + 1) * NUP + c; const float* t0 = TL + (size_t)((grp - 1) * 2) * NUP + c;
                u1a = *(const f32x4*)t1; u1v = *(const f32x4*)(t1 + DFF); u2a = *(const f32x4*)t0; u2v = *(const f32x4*)(t0 + DFF); }
        } else {
            const float* hp = HD + (size_t)(grp * 2) * NUP + c; u1a = *(const f32x4*)hp; u1v = *(const f32x4*)(hp + DFF);
            if (first) { u2a = z; u2v = z; } else { const float* t1 = TL + (size_t)((grp - 1) * 2 + 1) * NUP + c; u2a = *(const f32x4*)t1; u2v = *(const f32x4*)(t1 + DFF); }
        }
        const f32x4 w0a = *(const f32x4*)(cw + c), w1a = *(const f32x4*)(cw + NUP + c), w2a = *(const f32x4*)(cw + 2 * NUP + c), ba = *(const f32x4*)(cb + c);
        const f32x4 w0v = *(const f32x4*)(cw + DFF + c), w1v = *(const f32x4*)(cw + NUP + DFF + c), w2v = *(const f32x4*)(cw + 2 * NUP + DFF + c), bv = *(const f32x4*)(cb + DFF + c);
        const f32x4 ya = ba + w2a * u0a + w1a * u1a + w0a * u2a, yv = bv + w2v * u0v + w1v * u1v + w0v * u2v;
        float g[4];
#pragma unroll
        for (int k = 0; k < 4; ++k) g[k] = ya[k] * pg8::sigmoidf_fast(ya[k]) * yv[k];
        u32x2 w; w.x = pg8::cvt_pk_bf16(g[0], g[1]); w.y = pg8::cvt_pk_bf16(g[2], g[3]);
        *(u32x2*)(GF + (size_t)(grp * 64 + e) * DFF + c) = w;
    }
}


#ifdef SELFCHECK
constexpr size_t WS_DIAG = 512 * 1024;
__device__ __forceinline__ float bf2f(bf16 v) { return __uint_as_float(((unsigned)v) << 16); }
__device__ __forceinline__ void dbg_cmp(const Args& a, int stage, float got, float want, float tol) {
    const float err = fabsf(got - want); if (!(err <= tol * (fabsf(want) + 0.02f))) atomicMin((unsigned*)(a.ws + WS_DIAG), (unsigned)stage);
}
__device__ const int dbg_rows[8] = {0, 70, 1410, 10440, 8209, 8292, 20118, 32767};
__device__ __forceinline__ void selfcheck(const Args& a, int stage, int l) {
    const int tid = threadIdx.x, lane = tid & 63, wave = tid >> 6;
    const float* mod = (const float*)(a.ws + WS_MOD); const bf16* Hb = (const bf16*)(a.ws + WS_H);
    const bf16* Win = (const bf16*)(a.ws + WS_WIN) + (size_t)l * NPROJ * DM;
    float* dexp = (float*)(a.ws + WS_DIAG) + 1024;
    if (stage == 1 && tid < 64) { const int ll = tid & 1, b = (tid >> 1) & 3, j = (tid * 97) % NMOD; double s = a.b_ada[ll * NMOD + j];
        for (int k = 0; k < DM; ++k) { const double c = a.c[b * DM + k]; s += c / (1.0 + exp(-c)) * (double)a.w_ada[((size_t)ll * DM + k) * NMOD + j]; }
        dbg_cmp(a, 1, mod[((size_t)ll * BATCH + b) * NMOD + j], (float)s, 1e-3f); }
    if (stage == 2 && tid < 256) { const int k = (tid * 37) % DM;
        { const int d = (tid * 211) % NPROJ, seg = d >> 9; const int segsrc = seg == 0 ? 0 : seg == 1 ? 1544 : seg == 2 ? 512 : seg == 3 ? 2056 : seg == 4 ? 1024 : seg == 5 ? 2568 : 3080 + (seg - 6) * 512;
          dbg_cmp(a, 2, bf2f(((const bf16*)(a.ws + WS_WIN))[(size_t)d * DM + k]), a.w_in[(size_t)k * PROJ + segsrc + (d & 511)], 5e-3f); }
        { const int n = (tid * 13) % DM; dbg_cmp(a, 2, bf2f(((const bf16*)(a.ws + WS_WBR))[(size_t)n * DM + (k & 511)]), a.w_br_fox[(size_t)(k & 511) * DM + n], 5e-3f);
          dbg_cmp(a, 2, bf2f(((const bf16*)(a.ws + WS_WBR))[(size_t)n * DM + 512 + (k & 511)]), a.w_br_chunk[(size_t)(k & 511) * DM + n], 5e-3f);
          dbg_cmp(a, 2, bf2f(((const bf16*)(a.ws + WS_WOUT))[(size_t)n * DM + k]), a.w_out[(size_t)k * DM + n], 5e-3f);
          const int kk = (tid * 53) % DFF; dbg_cmp(a, 2, bf2f(((const bf16*)(a.ws + WS_WDN))[(size_t)n * DFF + kk]), a.w_down[(size_t)kk * DM + n], 5e-3f); }
        { const int d = (tid * 331) % NUP, pn = d >> 8, bj = (d >> 7) & 1, j = d & 127; dbg_cmp(a, 2, bf2f(((const bf16*)(a.ws + WS_WUP))[(size_t)d * DM + k]), a.w_up[(size_t)k * NUP + bj * DFF + 128 * pn + j], 5e-3f); } }
    if (stage == 3 && tid < 8) { const int row = dbg_rows[tid], b = row / SEQ; const float* x = a.x + (size_t)row * DM; double m = 0, q = 0;
        for (int k = 0; k < DM; ++k) m += x[k]; m /= DM; for (int k = 0; k < DM; ++k) q += (x[k] - m) * (x[k] - m); const double rs = 1.0 / sqrt(q / DM + 1e-5);
        double f[8] = {0, 0, 0, 0, 0, 0, 0, 0};
        for (int k = 0; k < DM; ++k) { const double h = (x[k] - m) * rs * (1.0 + mod[(size_t)b * NMOD + DM + k]) + mod[(size_t)b * NMOD + k];
            if ((k & 63) == 5) dbg_cmp(a, 3, bf2f(Hb[(size_t)row * DM + k]), (float)h, 1e-2f);
            for (int hh = 0; hh < 8; ++hh) f[hh] += h * (double)a.w_in[(size_t)k * PROJ + 1536 + hh]; }
        for (int hh = 0; hh < 8; ++hh) { const double z = f[hh] + a.b_f[hh]; dbg_cmp(a, 3, ((const float*)(a.ws + WS_LF))[(size_t)row * 8 + hh], (float)(-log1p(exp(-z))), 2e-3f); } }
    if (stage == 4 && tid < 32) { const int b = tid >> 3, hh = tid & 7, tt = 5000 + 97 * tid; double s = 0; for (int t = 0; t <= tt; ++t) s += ((const float*)(a.ws + WS_LF))[((size_t)b * SEQ + t) * 8 + hh];
        dbg_cmp(a, 4, ((const float*)(a.ws + WS_FL2))[((size_t)b * 8 + hh) * SEQ + tt], (float)(s * 1.4426950408889634), 1e-4f); }
    if (stage == 5) { unsigned* cnt = (unsigned*)(a.ws + WS_DIAG) + 16;
        for (int it = 0; it < 2; ++it) { const int row = (tid * 61 + it * 4099 + 7) % T, d = 1024 + (tid * 167 + it * 31 + 5) % 2048; const int hot = row & (DM - 1);
            int nz = 0; bool hotok = false; double s2 = 0;
            for (int k = 0; k < DM; ++k) { const float hv = bf2f(Hb[(size_t)row * DM + k]); if (hv != 0.f) ++nz; if (k == hot && hv == 1.0f) hotok = true; s2 += (double)hv * (double)bf2f(Win[(size_t)d * DM + k]); }
            const float got = (d < 2048) ? bf2f(((const bf16*)(a.ws + WS_K))[(size_t)row * DM + d - 1024]) : bf2f(((const bf16*)(a.ws + WS_V))[(size_t)row * DM + d - 2048]);
            atomicAdd(cnt + 0, 1u); if (nz == 1 && hotok) atomicAdd(cnt + 1, 1u); if (fabsf(got - (float)s2) <= 1.5e-2f * (fabsf((float)s2) + 0.02f)) atomicAdd(cnt + 2, 1u); } }
    if (stage == 60 || stage == 6) {
        const int smp = wave, row = dbg_rows[(smp * 3 + 2) & 7], b = row / SEQ, t = row % SEQ, h = (smp * 5 + 1) & 7, band = smp >= 4;
        const int hc = (band ? 512 : 0) + h * 64;
        const bf16* QQ = (const bf16*)(a.ws + WS_QQ); const bf16* KK = (const bf16*)(a.ws + WS_K); const bf16* VV = (const bf16*)(a.ws + WS_V);
        if (stage == 60) {
            const int c = t >> 6; const int s_lo = band ? ((c - 8 < 0 ? 0 : c - 8) << 6) : 0, s_hi = band ? (c << 6) + 63 : t;
            const float qd = bf2f(QQ[((size_t)b * SEQ + t) * DM + hc + lane]);
            float mx = -3e38f, lsum = 0.f, od = 0.f;
            for (int s2 = s_lo; s2 <= s_hi; ++s2) {
                float lg = wave_sum(qd * bf2f(KK[((size_t)b * SEQ + s2) * DM + hc + lane]));
                if (!band) lg -= ((const float*)(a.ws + WS_FL2))[((size_t)b * 8 + h) * SEQ + s2];
                else { int dd = t - s2; dd = dd > 128 ? 128 : (dd < -128 ? -128 : dd); lg += 1.4426950408889634f * a.rel_bias[((size_t)l * 8 + h) * 257 + dd + 128]; }
                const float mn = fmaxf(mx, lg), sc = exp2f(mx - mn), p = exp2f(lg - mn); mx = mn;
                lsum = lsum * sc + p; od = od * sc + p * bf2f(VV[((size_t)b * SEQ + s2) * DM + hc + lane]);
            }
            dexp[smp * 64 + lane] = od / lsum;
        } else if (lane < 64) { dbg_cmp(a, band ? 7 : 6, bf2f(QQ[((size_t)b * SEQ + t) * DM + hc + lane]), dexp[smp * 64 + lane], 3e-2f); }
    }
    if (stage == 80 || stage == 8) {
        if (stage == 8 && tid < 128) { const int row = dbg_rows[tid & 7], n = (tid * 59 + 3) % DM; const bf16* O = (const bf16*)(a.ws + WS_QQ); const bf16* Wbr = (const bf16*)(a.ws + WS_WBR) + (size_t)l * DM * DM;
            double sa = 0, sc = 0; for (int k = 0; k < 512; ++k) { sa += (double)bf2f(O[(size_t)row * DM + k]) * bf2f(Wbr[(size_t)n * DM + k]); sc += (double)bf2f(O[(size_t)row * DM + 512 + k]) * bf2f(Wbr[(size_t)n * DM + 512 + k]); }
            const bf16* GG = (const bf16*)(a.ws + WS_G); const double want = bf2f(GG[(size_t)row * 2048 + n]) * sa + bf2f(GG[(size_t)row * 2048 + 1024 + n]) * sc;
            dbg_cmp(a, 8, bf2f(Hb[(size_t)row * DM + n]), (float)want, 2e-2f); } }
    if (stage == 9 && tid < 128) { const int row = dbg_rows[tid & 7], n = (tid * 59 + 3) % DM; const bf16* Wo = (const bf16*)(a.ws + WS_WOUT) + (size_t)l * DM * DM; double s2 = 0;
        for (int k = 0; k < DM; ++k) s2 += (double)bf2f(Hb[(size_t)row * DM + k]) * bf2f(Wo[(size_t)n * DM + k]);
        dbg_cmp(a, 9, ((const float*)(a.ws + WS_MIX))[(size_t)row * DM + n], (float)s2, 5e-3f); }
    if (stage == 10 && tid < 8) { const int row = dbg_rows[tid], b = row / SEQ; const float* x = a.x + (size_t)row * DM; const float* mx = (const float*)(a.ws + WS_MIX) + (size_t)row * DM; const float* ml = mod + (size_t)b * NMOD;
        double m = 0, q = 0; for (int k = 0; k < DM; ++k) m += 1.4142135623730951 * x[k] + (1.0 + ml[2 * DM + k]) * mx[k]; m /= DM;
        for (int k = 0; k < DM; ++k) { const double v = 1.4142135623730951 * x[k] + (1.0 + ml[2 * DM + k]) * mx[k] - m; q += v * v; } const double rs = 1.0 / sqrt(q / DM + 1e-5);
        double m2 = 0, q2 = 0;
        for (int k = 0; k < DM; ++k) { const double x1 = (1.4142135623730951 * x[k] + (1.0 + ml[2 * DM + k]) * mx[k] - m) * rs * a.ln1_g[k] + a.ln1_b[k]; m2 += x1; if ((k & 31) == 3) dbg_cmp(a, 10, a.out[(size_t)row * DM + k], (float)x1, 1e-3f); } m2 /= DM;
        for (int k = 0; k < DM; ++k) { const double x1 = a.out[(size_t)row * DM + k]; q2 += (x1 - m2) * (x1 - m2); } const double rs2 = 1.0 / sqrt(q2 / DM + 1e-5);
        for (int k = 5; k < DM; k += 64) { const double h2 = (a.out[(size_t)row * DM + k] - m2) * rs2 * (1.0 + ml[4 * DM + k]) + ml[3 * DM + k]; dbg_cmp(a, 10, bf2f(Hb[(size_t)row * DM + k]), (float)h2, 1e-2f); } }
    if (stage == 11 && tid < 256) { const int row = dbg_rows[tid & 7], c = (tid * 89 + 7) % DFF, spos = row % SEQ; const bf16* Wu = (const bf16*)(a.ws + WS_WUP) + (size_t)l * NUP * DM;
        const int da = (c >> 7) * 256 + (c & 127), dv = da + 128; double ya = a.conv_b[c], yv = a.conv_b[DFF + c];
        for (int j = 0; j < 3; ++j) { const int sp = spos - 2 + j; if (sp < 0) continue; const size_t r2 = (size_t)row - 2 + j; double ua = 0, uv = 0;
            for (int k = 0; k < DM; ++k) { const double hv = bf2f(Hb[r2 * DM + k]); ua += hv * bf2f(Wu[(size_t)da * DM + k]); uv += hv * bf2f(Wu[(size_t)dv * DM + k]); }
            ya += a.conv_w[j * NUP + c] * ua; yv += a.conv_w[j * NUP + DFF + c] * uv; }
        dbg_cmp(a, 11, bf2f(((const bf16*)(a.ws + WS_GFF))[(size_t)row * DFF + c]), (float)(ya / (1.0 + exp(-ya)) * yv), 2e-2f); }
    if (stage == 12 && tid < 128) { const int row = dbg_rows[tid & 7], n = (tid * 59 + 3) % DM; const bf16* Wd = (const bf16*)(a.ws + WS_WDN) + (size_t)l * DM * DFF; const bf16* GF = (const bf16*)(a.ws + WS_GFF); double s2 = 0;
        for (int k = 0; k < DFF; ++k) s2 += (double)bf2f(GF[(size_t)row * DFF + k]) * bf2f(Wd[(size_t)n * DFF + k]);
        dbg_cmp(a, 12, ((const float*)(a.ws + WS_Y))[(size_t)row * DM + n], (float)s2, 5e-3f); }
    __syncthreads();
}
#define SC(st) do {} while (0)
#else
#define SC(st) do {} while (0)
#endif


constexpr size_t WS_BAR = 768 * 1024;
constexpr unsigned BAR_POISON = 0xAAAAAAAAu, NBAR = 32u;
__device__ __forceinline__ void gbar(unsigned* bw, unsigned k) {
    asm volatile("s_waitcnt vmcnt(0) lgkmcnt(0)" ::: "memory");
    __syncthreads();
    if (threadIdx.x == 0) {
        __builtin_amdgcn_fence(__ATOMIC_RELEASE, "agent");
        asm volatile("s_waitcnt vmcnt(0)" ::: "memory");
        unsigned zz = 0u; asm volatile("" : "+v"(zz));
        const unsigned G = gridDim.x + zz, g = (blockIdx.x + zz) & 7u;
        const unsigned ng = (G >> 3) + ((g < (G & 7u)) ? 1u : 0u), ngrp = G < 8u ? G : 8u;
        unsigned* cg = bw + 64u * g; unsigned* top = bw + 64u * 8u; unsigned* rel = bw + 64u * 9u;
        const unsigned per1 = NBAR * ng, perT = NBAR * ngrp;
        const unsigned nowT = __hip_atomic_load(top, __ATOMIC_RELAXED, __HIP_MEMORY_SCOPE_AGENT);
        const unsigned baseT = BAR_POISON + ((nowT - BAR_POISON) / perT) * perT;
        const unsigned relTarget = baseT + (k + 1u) * ngrp;
        const unsigned old = __hip_atomic_fetch_add(cg, 1u, __ATOMIC_RELAXED, __HIP_MEMORY_SCOPE_AGENT);
        const unsigned base1 = BAR_POISON + ((old - BAR_POISON) / per1) * per1;
        if (old + 1u == base1 + (k + 1u) * ng) {
            const unsigned oldT = __hip_atomic_fetch_add(top, 1u, __ATOMIC_RELAXED, __HIP_MEMORY_SCOPE_AGENT);
            if (oldT + 1u == relTarget) __hip_atomic_store(rel, relTarget, __ATOMIC_RELAXED, __HIP_MEMORY_SCOPE_AGENT);
        }
        while ((int)(__hip_atomic_load(rel, __ATOMIC_RELAXED, __HIP_MEMORY_SCOPE_AGENT) - relTarget) < 0) __builtin_amdgcn_s_sleep(1);
        __builtin_amdgcn_fence(__ATOMIC_ACQUIRE, "agent");
        asm volatile("s_waitcnt vmcnt(0)" ::: "memory");
    }
    __syncthreads();
}
__device__ __forceinline__ void gbar_pad(unsigned* bw, unsigned nb) {
    if (threadIdx.x == 0) {
        const unsigned G = gridDim.x, g = blockIdx.x & 7u, ngrp = G < 8u ? G : 8u;
        __hip_atomic_fetch_add(bw + 64u * g, NBAR - nb, __ATOMIC_RELAXED, __HIP_MEMORY_SCOPE_AGENT);
        if (blockIdx.x < ngrp) __hip_atomic_fetch_add(bw + 64u * 8u, NBAR - nb, __ATOMIC_RELAXED, __HIP_MEMORY_SCOPE_AGENT);
    }
}

template <int PHM_T> __global__ void __launch_bounds__(NWAVES * 64, 2) fwd_megakernel_t(Args a_unused) {
    extern __shared__ __attribute__((aligned(16))) unsigned char lds_raw[];
    LAS unsigned char* lds = (LAS unsigned char*)lds_raw;
    cg::grid_group grid = cg::this_grid();
#ifdef MULTI
#define GSYNCK(K) do {} while (0)
#else
#define GSYNCK(K) do { KArgP apb_ = (KArgP)__builtin_amdgcn_kernarg_segment_ptr(); asm volatile("" : "+s"(apb_)); gbar((unsigned*)(apb_->ws + WS_BAR), (K)); } while (0)
#endif
    unsigned bar_idx = 0u; (void)bar_idx;
#ifndef MULTI
    grid.sync();
#endif
    typedef const __attribute__((address_space(4))) Args* KArgP;
#if defined(__HIP_DEVICE_COMPILE__)
#define FRESH_ARGS() KArgP ap_ = (KArgP)__builtin_amdgcn_kernarg_segment_ptr(); asm volatile("" : "+s"(ap_)); Args a; \
    a.x = ap_->x; a.c = ap_->c; a.w_in = ap_->w_in; a.b_f = ap_->b_f; a.rel_bias = ap_->rel_bias; a.w_br_fox = ap_->w_br_fox; a.w_br_chunk = ap_->w_br_chunk; a.w_out = ap_->w_out; a.w_up = ap_->w_up; \
    a.conv_w = ap_->conv_w; a.conv_b = ap_->conv_b; a.w_down = ap_->w_down; a.w_ada = ap_->w_ada; a.b_ada = ap_->b_ada; a.ln1_g = ap_->ln1_g; a.ln1_b = ap_->ln1_b; a.ln2_g = ap_->ln2_g; a.ln2_b = ap_->ln2_b; \
    a.out = ap_->out; a.ws = ap_->ws; a.phm = ap_->phm; a.pad = 0; const int G = opq_s((int)gridDim.x); const int BX = opq_s(BX); \
    const float* mod = (const float*)(a.ws + WS_MOD); bf16* Hb = (bf16*)(a.ws + WS_H); (void)mod; (void)Hb; (void)BX
#else
#define FRESH_ARGS() const Args a = a_unused; const int G = 1, BX = 0; const float* mod = nullptr; bf16* Hb = nullptr; (void)mod; (void)Hb; (void)BX
#endif

#ifdef MULTI
    const int phm_rt = a_unused.phm, l_lo = a_unused.pad & 0xff, l_hi = a_unused.pad >> 8;
#define PHM phm_rt
#else
#define PHM PHM_T
#endif
    { FRESH_ARGS();
      if (blockIdx.x == 0 && threadIdx.x < 128) ((unsigned*)(a.ws + WS_KN))[threadIdx.x] = 0u;
      if (PHM & 1) mod_phase(a, lds, G); if (PHM & 2) weights_phase(a, lds, G); }
    GSYNCK(0u);
    { const int l = 0; SC(1); SC(2); }
    { FRESH_ARGS(); if (PHM & 4) ln_pass<false, true, true>(a, lds, G, a.x, nullptr, nullptr, nullptr, nullptr, nullptr, mod + 1 * DM, mod + 0 * DM, 0); }
    GSYNCK(1u);
#ifdef SELFCHECK_ONEHOT_DISABLED
    { FRESH_ARGS(); for (size_t i = (size_t)blockIdx.x * 512 + threadIdx.x; i < (size_t)T * DM / 2; i += (size_t)G * 512) { const int row = (int)(i / (DM / 2)), k2 = (int)(i % (DM / 2)) * 2; const int hot = row & (DM - 1); ((unsigned*)Hb)[i] = (k2 == hot) ? 0x00003F80u : (k2 + 1 == hot) ? 0x3F800000u : 0u; } }
    GSYNCK(999u);
#endif

#ifndef NL_RUN
#define NL_RUN NL
#endif
#ifdef MULTI
    for (int l = l_lo; l < l_hi; ++l) {
#else
    for (int l = 0; l < NL_RUN; ++l) {
#endif
        { FRESH_ARGS(); if (PHM & 8) scan_phase(a, lds, G); }
        __syncthreads();
        if (PHM & 16) { FRESH_ARGS();
#ifdef SELFCHECK
            for (int zi = threadIdx.x; zi < 131072 / 4; zi += 512) ((LAS unsigned*)lds)[zi] = 0u; __syncthreads();
#endif
            pg8::Gemm g{Hb, (const bf16*)(a.ws + WS_WIN) + (size_t)l * NPROJ * DM, T, NPROJ, DM, DM, DM};
            pg8::StaticOrder S; S.init(T, NPROJ, (int)gridDim.x, (int)blockIdx.x);
            pg8::EpiProj E{(bf16*)(a.ws + WS_QQ), (bf16*)(a.ws + WS_K), (bf16*)(a.ws + WS_V), (bf16*)(a.ws + WS_G)};
            pg8::gemm_phase<pg8::EpiProj, pg8::StaticOrder, true, true>(lds, g, S, E);
        }
        GSYNCK((2u + 10u * (unsigned)l + 0u));
        SC(4); SC(5); SC(60);
        { FRESH_ARGS(); if (PHM & 32) knorm_phase(a, lds, G, l); }
        GSYNCK((2u + 10u * (unsigned)l + 1u));
        { FRESH_ARGS(); if (PHM & 32) attn_phase(a, lds, G, l); }
        GSYNCK((2u + 10u * (unsigned)l + 2u));
        SC(6);
        if (PHM & 64) {
            FRESH_ARGS();
            pg8::Gemm g{(const bf16*)(a.ws + WS_QQ), (const bf16*)(a.ws + WS_WBR) + (size_t)l * DM * DM, T, DM, DM, DM, DM};
            pg8::StaticOrder S; S.init(T, DM, (int)gridDim.x, (int)blockIdx.x);
            pg8::EpiMergeK E{Hb, (const bf16*)(a.ws + WS_G)};
            pg8::gemm_phase<pg8::EpiMergeK, pg8::StaticOrder, true, true>(lds, g, S, E);
        }
        GSYNCK((2u + 10u * (unsigned)l + 3u));
        SC(8);
        if (PHM & 128) {
            FRESH_ARGS();
            pg8::Gemm g{Hb, (const bf16*)(a.ws + WS_WOUT) + (size_t)l * DM * DM, T, DM, DM, DM, DM};
            pg8::StaticOrder S; S.init(T, DM, (int)gridDim.x, (int)blockIdx.x);
            pg8::EpiBf16P E{(bf16*)(a.ws + WS_MIX), DM};
            pg8::gemm_phase<pg8::EpiBf16P, pg8::StaticOrder, true, true>(lds, g, S, E);
        }
        GSYNCK((2u + 10u * (unsigned)l + 4u));
        SC(9);
        if (PHM & 256) { FRESH_ARGS(); const float* modl = mod + (size_t)l * BATCH * NMOD; const float* xcur = (l == 0) ? a.x : a.out;
            ln_pass<true, true, false>(a, lds, G, xcur, (const bf16*)(a.ws + WS_MIX), a.out, modl + 2 * DM, a.ln1_g + l * DM, a.ln1_b + l * DM, modl + 4 * DM, modl + 3 * DM, 0); }
        GSYNCK((2u + 10u * (unsigned)l + 5u));
        SC(10);
        if (PHM & 512) {
            FRESH_ARGS();
            pg8::Gemm g{Hb, (const bf16*)(a.ws + WS_WUP) + (size_t)l * NUP * DM, T, NUP, DM, DM, DM};
            pg8::StaticOrder S; S.init(T, NUP, (int)gridDim.x, (int)blockIdx.x);
            pg8::EpiUp E{(bf16*)(a.ws + WS_GFF), (float*)(a.ws + WS_HD), (float*)(a.ws + WS_TL), a.conv_w + (size_t)l * 3 * NUP, a.conv_b + (size_t)l * NUP};
            pg8::gemm_phase<pg8::EpiUp, pg8::StaticOrder, true, true>(lds, g, S, E);
        }
        GSYNCK((2u + 10u * (unsigned)l + 6u));
        { FRESH_ARGS(); if (PHM & 1024) fixup_phase(a, G, l); }
        GSYNCK((2u + 10u * (unsigned)l + 7u));
        SC(11);
        if (PHM & 2048) {
            FRESH_ARGS();
            pg8::Gemm g{(const bf16*)(a.ws + WS_GFF), (const bf16*)(a.ws + WS_WDN) + (size_t)l * DM * DFF, T, DM, DFF, DFF, DFF};
            pg8::StaticOrder S; S.init(T, DM, (int)gridDim.x, (int)blockIdx.x);
            pg8::EpiBf16P E{(bf16*)(a.ws + WS_Y), DM};
            pg8::gemm_phase<pg8::EpiBf16P, pg8::StaticOrder, true, true>(lds, g, S, E);
        }
        GSYNCK((2u + 10u * (unsigned)l + 8u));
        SC(12);
        if (l + 1 < NL) {
            { FRESH_ARGS(); const float* modl = mod + (size_t)l * BATCH * NMOD; const float* modn = mod + (size_t)(l + 1) * BATCH * NMOD;
            if (PHM & 4096) ln_pass<true, true, true>(a, lds, G, a.out, (const bf16*)(a.ws + WS_Y), a.out, modl + 5 * DM, a.ln2_g + l * DM, a.ln2_b + l * DM, modn + 1 * DM, modn + 0 * DM, l + 1); }
            GSYNCK((2u + 10u * (unsigned)l + 9u));
        } else {
            FRESH_ARGS(); const float* modl = mod + (size_t)l * BATCH * NMOD;
            if (PHM & 8192) ln_pass<true, false, false>(a, lds, G, a.out, (const bf16*)(a.ws + WS_Y), a.out, modl + 5 * DM, a.ln2_g + l * DM, a.ln2_b + l * DM, nullptr, nullptr, 0);
        }
    }
#ifndef MULTI
    { KArgP apb_ = (KArgP)__builtin_amdgcn_kernarg_segment_ptr(); asm volatile("" : "+s"(apb_)); gbar_pad((unsigned*)(apb_->ws + WS_BAR), 2u + 10u * (unsigned)NL - 1u); }
#endif
}


#ifdef SELFCHECK
__global__ void __launch_bounds__(512) check_kernel(Args a, int which) {
    if (which == 0) { if (threadIdx.x < 128) ((unsigned*)(a.ws + WS_DIAG))[threadIdx.x] = threadIdx.x == 0 ? 1000u : 0u; return; }
    if (which == 1) { selfcheck(a, 5, 0); }
    if (which == 2) { selfcheck(a, 9, 0); }
    if (which == 6) { selfcheck(a, 8, 0); }
    if (which == 3) selfcheck(a, 10, 0);
    if (which == 4) selfcheck(a, 11, 0);
    if (which == 5) selfcheck(a, 12, 0);
    if (which == 9) { if (threadIdx.x == 0) { const unsigned dg = *(volatile unsigned*)(a.ws + WS_DIAG); if (dg < 1000u) a.out[0] = 1e4f * (float)dg; const unsigned* cnt = (const unsigned*)(a.ws + WS_DIAG) + 16; int mant = (int)(99.f * (float)cnt[1] / (float)(cnt[0] + 1u)); mant = mant < 10 ? 10 : mant; int ex = (int)(10.f * (float)cnt[2] / (float)(cnt[0] + 1u) + 0.5f); a.out[0] = (float)mant * __powf(10.f, 2.f + (float)ex); } }
}
#endif

#ifdef SELFCHECK
__global__ void __launch_bounds__(512) dma_test(unsigned char* ws) {
    extern __shared__ __attribute__((aligned(16))) unsigned char lds_raw2[];
    LAS unsigned char* lds = (LAS unsigned char*)lds_raw2;
    const int tid = threadIdx.x, wid = __builtin_amdgcn_readfirstlane(tid >> 6), lane = tid & 63;
    unsigned* src = (unsigned*)(ws + 600 * 1024);
    for (int i = tid; i < 32768; i += 512) src[i] = (unsigned)i * 2654435761u;
    for (int i = tid; i < 131072 / 4; i += 512) ((LAS unsigned*)lds)[i] = 0u;
    __threadfence(); __syncthreads();
    const unsigned bases[6] = {0u, 0x6000u, 0xE000u, 0x10000u, 0x16000u, 0x1E000u};
    unsigned bad = 0;
#pragma unroll
    for (int b = 0; b < 6; ++b) {
        __builtin_amdgcn_global_load_lds((const unsigned*)((const char*)src + b * 8192 + tid * 16), (LAS unsigned*)(lds + bases[b] + wid * 1024), 16, 0, 0);
    }
    asm volatile("s_waitcnt vmcnt(0)" ::: "memory"); __syncthreads();
#pragma unroll
    for (int b = 0; b < 6; ++b) {
        const u32x4 v = *(const LAS u32x4*)(lds + bases[b] + tid * 16);
        const unsigned w0 = (unsigned)(b * 2048 + tid * 4);
        if (v.x != w0 * 2654435761u || v.y != (w0 + 1) * 2654435761u || v.z != (w0 + 2) * 2654435761u || v.w != (w0 + 3) * 2654435761u) bad |= 1u << b;
    }
    if (bad) atomicOr((unsigned*)(ws + WS_DIAG) + 100, bad);
}
#endif

#ifdef SELFCHECK
struct OneUnit { __device__ bool next(int i, pg8::Unit& u) const { if (i > 0) return false; u.pm = 0; u.pn = 0; return true; }
                 __device__ void a_ready(const pg8::Unit&) const {} __device__ void done(const pg8::Unit&) const {} };
__global__ void __launch_bounds__(512, 2) engine_test(unsigned char* ws) {
    extern __shared__ __attribute__((aligned(16))) unsigned char lds_raw3[];
    LAS unsigned char* lds = (LAS unsigned char*)lds_raw3;
    bf16* A = (bf16*)(ws + 8 * MiB); bf16* B = A + 256 * 128; float* C0 = (float*)(ws + 9 * MiB); float* C1 = C0 + 65536;
    const int tid = threadIdx.x;
    for (int i = tid; i < 256 * 128; i += 512) { const int m = i >> 7, k = i & 127; A[i] = (bf16)f2bf((float)((m * 7 + k * 3) % 13 - 6) * 0.125f); B[i] = (bf16)f2bf((float)((m * 5 + k) % 11 - 5) * 0.125f); }
    __threadfence(); __syncthreads();
    pg8::Gemm g{A, B, 256, 256, 128, 128, 128}; OneUnit S;
    { pg8::EpiF32 E{C0, 256}; pg8::sgemm_phase<pg8::EpiF32, OneUnit>(lds, g, S, E); }
    __threadfence(); __syncthreads();
    { pg8::EpiF32 E{C1, 256}; pg8::gemm_phase<pg8::EpiF32, OneUnit, true, true>(lds, g, S, E); }
    __threadfence(); __syncthreads();
    unsigned ok0 = 0, ok1 = 0;
    for (int i = tid; i < 65536; i += 512) { const int m = i >> 8, n = i & 255; float s2 = 0.f;
        for (int k = 0; k < 128; ++k) s2 += (float)((m * 7 + k * 3) % 13 - 6) * 0.125f * ((float)((n * 5 + k) % 11 - 5) * 0.125f);
        if (fabsf(C0[i] - s2) < 1e-3f) ++ok0; if (fabsf(C1[i] - s2) < 1e-3f) ++ok1; }
    atomicAdd((unsigned*)(ws + WS_DIAG) + 110, ok0); atomicAdd((unsigned*)(ws + WS_DIAG) + 111, ok1);
}
#endif

#ifdef SEPK
#define SEPK_LDS() extern __shared__ __attribute__((aligned(16))) unsigned char lds_rawk[]; LAS unsigned char* lds = (LAS unsigned char*)lds_rawk; const int G = gridDim.x; const int BX = blockIdx.x; (void)G; (void)BX; const float* mod = (const float*)(a.ws + WS_MOD); bf16* Hb = (bf16*)(a.ws + WS_H); (void)mod; (void)Hb
__global__ void __launch_bounds__(512, 2) k_prologue(Args a) { SEPK_LDS(); mod_phase(a, lds, G); weights_phase(a, lds, G); }
__global__ void __launch_bounds__(512, 2) k_ln0(Args a) { SEPK_LDS(); ln_pass<false, true, true>(a, lds, G, a.x, nullptr, nullptr, nullptr, nullptr, nullptr, mod + 1 * DM, mod + 0 * DM, 0); }
__global__ void __launch_bounds__(512, 2) k_scan(Args a) { SEPK_LDS(); scan_phase(a, lds, G); }
__global__ void __launch_bounds__(512, 2) k_proj(Args a, int l) { SEPK_LDS();
    pg8::Gemm g{Hb, (const bf16*)(a.ws + WS_WIN) + (size_t)l * NPROJ * DM, T, NPROJ, DM, DM, DM}; pg8::StaticOrder S; S.init(T, NPROJ, (int)gridDim.x, (int)blockIdx.x);
    pg8::EpiProj E{(bf16*)(a.ws + WS_QQ), (bf16*)(a.ws + WS_K), (bf16*)(a.ws + WS_V), (bf16*)(a.ws + WS_G)}; pg8::gemm_phase<pg8::EpiProj, pg8::StaticOrder, true, true>(lds, g, S, E); }
__global__ void __launch_bounds__(512, 2) k_attn(Args a, int l) { SEPK_LDS(); attn_phase(a, lds, G, l); }
__global__ void __launch_bounds__(512, 2) k_merge(Args a, int l) { SEPK_LDS();
    pg8::Gemm g{(const bf16*)(a.ws + WS_QQ), (const bf16*)(a.ws + WS_WBR) + (size_t)l * DM * DM, T, DM, DM, DM, DM}; pg8::StaticOrder S; S.init(T, DM, (int)gridDim.x, (int)blockIdx.x);
    pg8::EpiMergeK E{Hb, (const bf16*)(a.ws + WS_G)}; pg8::gemm_phase<pg8::EpiMergeK, pg8::StaticOrder, true, true>(lds, g, S, E); }
__global__ void __launch_bounds__(512, 2) k_out(Args a, int l) { SEPK_LDS();
    pg8::Gemm g{Hb, (const bf16*)(a.ws + WS_WOUT) + (size_t)l * DM * DM, T, DM, DM, DM, DM}; pg8::StaticOrder S; S.init(T, DM, (int)gridDim.x, (int)blockIdx.x);
    pg8::EpiF32 E{(float*)(a.ws + WS_MIX), DM}; pg8::gemm_phase<pg8::EpiF32, pg8::StaticOrder, true, true>(lds, g, S, E); }
__global__ void __launch_bounds__(512, 2) k_lnmid(Args a, int l) { SEPK_LDS(); const float* modl = mod + (size_t)l * BATCH * NMOD; const float* xcur = (l == 0) ? a.x : a.out;
    ln_pass<true, true, false>(a, lds, G, xcur, (const bf16*)(a.ws + WS_MIX), a.out, modl + 2 * DM, a.ln1_g + l * DM, a.ln1_b + l * DM, modl + 4 * DM, modl + 3 * DM, 0); }
__global__ void __launch_bounds__(512, 2) k_up(Args a, int l) { SEPK_LDS();
    pg8::Gemm g{Hb, (const bf16*)(a.ws + WS_WUP) + (size_t)l * NUP * DM, T, NUP, DM, DM, DM}; pg8::StaticOrder S; S.init(T, NUP, (int)gridDim.x, (int)blockIdx.x);
    pg8::EpiUp E{(bf16*)(a.ws + WS_GFF), (float*)(a.ws + WS_HD), (float*)(a.ws + WS_TL), a.conv_w + (size_t)l * 3 * NUP, a.conv_b + (size_t)l * NUP}; pg8::gemm_phase<pg8::EpiUp, pg8::StaticOrder, true, true>(lds, g, S, E); }
__global__ void __launch_bounds__(512, 2) k_fixup(Args a, int l) { SEPK_LDS(); fixup_phase(a, G, l); }
__global__ void __launch_bounds__(512, 2) k_down(Args a, int l) { SEPK_LDS();
    pg8::Gemm g{(const bf16*)(a.ws + WS_GFF), (const bf16*)(a.ws + WS_WDN) + (size_t)l * DM * DFF, T, DM, DFF, DFF, DFF}; pg8::StaticOrder S; S.init(T, DM, (int)gridDim.x, (int)blockIdx.x);
    pg8::EpiF32 E{(float*)(a.ws + WS_Y), DM}; pg8::gemm_phase<pg8::EpiF32, pg8::StaticOrder, true, true>(lds, g, S, E); }
__global__ void __launch_bounds__(512, 2) k_lnend(Args a, int l) { SEPK_LDS(); const float* modl = mod + (size_t)l * BATCH * NMOD;
    if (l + 1 < NL) { const float* modn = mod + (size_t)(l + 1) * BATCH * NMOD;
        ln_pass<true, true, true>(a, lds, G, a.out, (const bf16*)(a.ws + WS_Y), a.out, modl + 5 * DM, a.ln2_g + l * DM, a.ln2_b + l * DM, modn + 1 * DM, modn + 0 * DM, l + 1); }
    else ln_pass<true, false, false>(a, lds, G, a.out, (const bf16*)(a.ws + WS_Y), a.out, modl + 5 * DM, a.ln2_g + l * DM, a.ln2_b + l * DM, nullptr, nullptr, 0); }
#endif
#ifndef PHM_A
#define PHM_A 0x3ffff
#endif
#define MK_MAIN fwd_megakernel_t<PHM_A>

#ifdef SELFCHECK
__global__ void __launch_bounds__(512, 2) proj_test(Args a) {
    extern __shared__ __attribute__((aligned(16))) unsigned char lds_raw4[];
    LAS unsigned char* lds = (LAS unsigned char*)lds_raw4;
    pg8::Gemm g{(const bf16*)(a.ws + WS_H), (const bf16*)(a.ws + WS_WIN), T, NPROJ, DM, DM, DM};
    pg8::StaticOrder S; S.init(T, NPROJ, (int)gridDim.x, (int)blockIdx.x);
    pg8::EpiProj E{(bf16*)(a.ws + WS_QQ), (bf16*)(a.ws + WS_K), (bf16*)(a.ws + WS_V), (bf16*)(a.ws + WS_G)};
    pg8::gemm_phase<pg8::EpiProj, pg8::StaticOrder, true, true>(lds, g, S, E);
}
#endif

#ifdef DETCHECK
constexpr size_t WS_DET = 512 * 1024;
__global__ void __launch_bounds__(512) cksum_kernel(const unsigned* p, size_t nwords, const unsigned* p2, size_t nwords2, unsigned* slot) {
    unsigned s = 0u;
    for (size_t i = (size_t)blockIdx.x * 512 + threadIdx.x; i < nwords; i += (size_t)gridDim.x * 512) s += p[i] * 2654435761u + (unsigned)i;
    for (size_t i = (size_t)blockIdx.x * 512 + threadIdx.x; i < nwords2; i += (size_t)gridDim.x * 512) s += p2[i] * 40503u + (unsigned)i;
#pragma unroll
    for (int o = 1; o < 64; o <<= 1) s += __shfl_xor(s, o);
    if ((threadIdx.x & 63) == 0) atomicAdd(slot, s);
}
__global__ void det_init(unsigned* slots) { if (threadIdx.x < 64) slots[threadIdx.x] = 0u; }
__global__ void det_report(const unsigned* slots, float* out) { if (threadIdx.x == 0) { for (int i = 0; i < 20; ++i) if (slots[i] != slots[20 + i]) { out[0] = 1e4f * (float)(i + 1); break; } } }
#endif
extern "C" void kernel_launch(void* const* d_in, const int* in_sizes, int n_in, void* d_out, int out_size, void* d_ws, size_t ws_size, hipStream_t stream) {
    static int grid = 0;
    if (grid == 0) {
        if (n_in != 18 || in_sizes[0] != T * DM || out_size != T * DM || ws_size < WS_END) { fprintf(stderr, "kernel_launch: unexpected shapes (n_in %d, in0 %d, out %d, ws %zu)\n", n_in, n_in > 0 ? in_sizes[0] : -1, out_size, ws_size); grid = -1; return; }
        int dev = 0, cus = 0, per_cu = 0;
        if (hipGetDevice(&dev) != hipSuccess || hipDeviceGetAttribute(&cus, hipDeviceAttributeMultiprocessorCount, dev) != hipSuccess) { grid = -1; return; }
        if (hipFuncSetAttribute((const void*)MK_MAIN, hipFuncAttributeMaxDynamicSharedMemorySize, LDS_BYTES) != hipSuccess) { fprintf(stderr, "kernel_launch: hipFuncSetAttribute failed\n"); grid = -1; return; }
        if (hipOccupancyMaxActiveBlocksPerMultiprocessor(&per_cu, (const void*)MK_MAIN, NWAVES * 64, LDS_BYTES) != hipSuccess || per_cu < 1) per_cu = 1;
        (void)hipGetLastError();
        grid = cus;
    }
    if (grid < 0) return;
    Args a{};
    a.x = (const float*)d_in[0]; a.c = (const float*)d_in[1]; a.w_in = (const float*)d_in[2]; a.b_f = (const float*)d_in[3]; a.rel_bias = (const float*)d_in[4];
    a.w_br_fox = (const float*)d_in[5]; a.w_br_chunk = (const float*)d_in[6]; a.w_out = (const float*)d_in[7]; a.w_up = (const float*)d_in[8]; a.conv_w = (const float*)d_in[9];
    a.conv_b = (const float*)d_in[10]; a.w_down = (const float*)d_in[11]; a.w_ada = (const float*)d_in[12]; a.b_ada = (const float*)d_in[13];
    a.ln1_g = (const float*)d_in[14]; a.ln1_b = (const float*)d_in[15]; a.ln2_g = (const float*)d_in[16]; a.ln2_b = (const float*)d_in[17];
    a.out = (float*)d_out; a.ws = (unsigned char*)d_ws;
    void* args[] = {&a};
    (void)hipMemsetAsync((unsigned char*)d_ws + WS_BAR, 0xAA, 64 * 10 * 4, stream);
#ifdef SELFCHECK
    hipLaunchKernelGGL(check_kernel, dim3(1), dim3(512), 0, stream, a, 0);
    (void)hipFuncSetAttribute((const void*)dma_test, hipFuncAttributeMaxDynamicSharedMemorySize, LDS_BYTES);
    hipLaunchKernelGGL(dma_test, dim3(1), dim3(512), LDS_BYTES, stream, (unsigned char*)d_ws);
    (void)hipFuncSetAttribute((const void*)engine_test, hipFuncAttributeMaxDynamicSharedMemorySize, LDS_BYTES);
    hipLaunchKernelGGL(engine_test, dim3(1), dim3(512), LDS_BYTES, stream, (unsigned char*)d_ws);
    { hipError_t e = hipLaunchCooperativeKernel((const void*)MK_MAIN, dim3(grid), dim3(NWAVES * 64), args, LDS_BYTES, stream);
      if (e != hipSuccess) fprintf(stderr, "cooperative launch failed: %s (grid %d)\n", hipGetErrorString(e), grid); }
#ifdef PHM_B
    { (void)hipFuncSetAttribute((const void*)fwd_megakernel_t<PHM_B>, hipFuncAttributeMaxDynamicSharedMemorySize, LDS_BYTES); hipError_t e = hipLaunchCooperativeKernel((const void*)fwd_megakernel_t<PHM_B>, dim3(grid), dim3(NWAVES * 64), args, LDS_BYTES, stream);
      if (e != hipSuccess) fprintf(stderr, "cooperative launch B failed: %s\n", hipGetErrorString(e)); }
#endif
#ifdef PROJTEST
    (void)hipFuncSetAttribute((const void*)proj_test, hipFuncAttributeMaxDynamicSharedMemorySize, LDS_BYTES);
    hipLaunchKernelGGL(proj_test, dim3(256), dim3(512), LDS_BYTES, stream, a);
#endif
    hipLaunchKernelGGL(check_kernel, dim3(1), dim3(512), 0, stream, a, SELFCHECK);
    hipLaunchKernelGGL(check_kernel, dim3(1), dim3(512), 0, stream, a, 9);
#elif defined(SEPK)
    {
#define LK(k, ...) do { static bool once_##k = false; if (!once_##k) { (void)hipFuncSetAttribute((const void*)k, hipFuncAttributeMaxDynamicSharedMemorySize, LDS_BYTES); once_##k = true; } hipLaunchKernelGGL(k, dim3(grid), dim3(512), LDS_BYTES, stream, __VA_ARGS__); } while (0)
        LK(k_prologue, a); LK(k_ln0, a);
        for (int l = 0; l < NL; ++l) { LK(k_scan, a); LK(k_proj, a, l); LK(k_attn, a, l); LK(k_merge, a, l); LK(k_out, a, l); LK(k_lnmid, a, l); LK(k_up, a, l); LK(k_fixup, a, l); LK(k_down, a, l); LK(k_lnend, a, l); }
    }
    if (0) {
#elif defined(MULTI)
    {
        const int seq[][3] = {{3, 0, 0}, {4, 0, 0},
            {24, 0, 1}, {32, 0, 1}, {64, 0, 1}, {128, 0, 1}, {256, 0, 1}, {512, 0, 1}, {1024, 0, 1}, {2048, 0, 1}, {4096, 0, 1},
            {24, 1, 2}, {32, 1, 2}, {64, 1, 2}, {128, 1, 2}, {256, 1, 2}, {512, 1, 2}, {1024, 1, 2}, {2048, 1, 2}, {8192, 1, 2}};
#ifdef DETCHECK
        hipLaunchKernelGGL(det_init, dim3(1), dim3(64), 0, stream, (unsigned*)((unsigned char*)d_ws + WS_DET));
        for (int run = 0; run < 2; ++run)
        for (int i = 0; i < 20; ++i) { a.phm = seq[i][0]; a.pad = seq[i][1] | (seq[i][2] << 8);
            hipLaunchKernelGGL(MK_MAIN, dim3(grid), dim3(NWAVES * 64), LDS_BYTES, stream, a);
            hipLaunchKernelGGL(cksum_kernel, dim3(1024), dim3(512), 0, stream, (const unsigned*)((unsigned char*)d_ws + MiB), (size_t)(449 * MiB / 4), (const unsigned*)d_out, (size_t)T * DM, (unsigned*)((unsigned char*)d_ws + WS_DET) + run * 20 + i); }
        hipLaunchKernelGGL(det_report, dim3(1), dim3(64), 0, stream, (const unsigned*)((unsigned char*)d_ws + WS_DET), (float*)d_out);
#else
        for (int i = 0; i < 20; ++i) { a.phm = seq[i][0]; a.pad = seq[i][1] | (seq[i][2] << 8);
            hipLaunchKernelGGL(MK_MAIN, dim3(grid), dim3(NWAVES * 64), LDS_BYTES, stream, a); }
#endif
    }
    if (0) {
#else
    a.phm = 0x3ffff;
    hipError_t e = hipLaunchCooperativeKernel((const void*)MK_MAIN, dim3(grid), dim3(NWAVES * 64), args, LDS_BYTES, stream);
    if (e != hipSuccess) fprintf(stderr, "cooperative launch failed: %s (grid %d)\n", hipGetErrorString(e), grid);
#endif
#if defined(MULTI) || defined(SEPK)
    }
#endif
}
```

```cpp
#include <hip/hip_runtime.h>
#include <hip/hip_cooperative_groups.h>
#include <cstdio>
#include <cstdint>
namespace cg = cooperative_groups;

namespace pg8 {
#define PG8_LAS __attribute__((address_space(3)))
typedef unsigned short bf16_t;
typedef short bf16x8 __attribute__((ext_vector_type(8)));
typedef float f32x4 __attribute__((ext_vector_type(4)));
typedef unsigned u32x4 __attribute__((ext_vector_type(4)));
typedef unsigned u32x2 __attribute__((ext_vector_type(2)));
constexpr int BM = 256, BK = 64, HALF = 128, HTB = HALF * BK * 2  , STAGE_BYTES = 8 * HTB, NXCD = 8, WGM = 8;

__host__ __device__ __forceinline__ int lds_byte(int r, int c) { const int st = (r >> 4) * 2 + (c >> 5), rr = r & 15, cc = c & 31, ob = rr * 64 + cc * 2; return st * 1024 + (ob ^ (((ob >> 9) & 1) << 5)); }
__host__ __device__ __forceinline__ void stage_rc(int b, int& R, int& C) { const int st = b / 1024, sb = b % 1024, swz = sb ^ (((sb >> 9) & 1) << 5); R = (st >> 1) * 16 + swz / 64; C = (st & 1) * 32 + (swz % 64) / 2; }
__host__ __device__ __forceinline__ int perm32(int rho) { const int n = rho >> 4, i = rho & 15; return 8 * (i >> 2) + 4 * n + (i & 3); }

struct Unit { int pm, pn; };
struct Gemm { const bf16_t* A; const bf16_t* Bt; int M, N, K, lda, ldb; };

struct StaticOrder {
    int nM, nN, nwg, G, c;
    __host__ __device__ void init(int M, int N, int G_, int c_) { nM = M / BM; nN = N / BM; nwg = nM * nN; G = G_; c = c_; }
    __host__ __device__ bool next(int i, Unit& u) const {
        const long L = (long)i * G + c; if (L >= nwg) return false;
        int wgid = (int)L; { const int q = nwg / NXCD, r = nwg % NXCD, xcd = wgid % NXCD, off = wgid / NXCD; wgid = (xcd < r ? xcd * (q + 1) : r * (q + 1) + (xcd - r) * q) + off; }
        const int nig = WGM * nN, gid = wgid / nig, fm = gid * WGM, gsz = (nM - fm) < WGM ? (nM - fm) : WGM;
        u.pm = fm + ((wgid % nig) % gsz); u.pn = (wgid % nig) / gsz; return true;
    }
    __device__ __forceinline__ void a_ready(const Unit&) const {}
    __device__ __forceinline__ void done(const Unit&) const {}
};

__device__ __forceinline__ unsigned cvt_pk_bf16(float lo, float hi) { unsigned r; asm volatile("v_cvt_pk_bf16_f32 %0, %1, %2" : "=v"(r) : "v"(lo), "v"(hi)); return r; }
__device__ __forceinline__ float bf_lo(unsigned w) { return __uint_as_float(w << 16); }
__device__ __forceinline__ float bf_hi(unsigned w) { return __uint_as_float(w & 0xffff0000u); }
__device__ __forceinline__ float sigmoidf_fast(float v) { return __builtin_amdgcn_rcpf(1.0f + __builtin_amdgcn_exp2f(-1.4426950408889634f * v)); }
constexpr float ATT_C2 = 0.125f * 1.4426950408889634f;

struct EpiProj {
    static constexpr bool PERM = true, AFTER_DRAIN = false, MIDK = false;
    bf16_t *QQ, *KK, *VV, *GG;
    __device__ __forceinline__ void operator()(const f32x4 (&acc)[2][2][4][2], const Unit& u, int wr, int wc, int fr, int fq) const {
        const int row0 = u.pm * BM + wr * 64 + fr; const int pn = u.pn;
        bf16_t* base; int ldc = 1024, colt; float sc = 1.f; bool sig = false;
        if (pn < 4) { base = QQ; colt = pn * 256; sc = ATT_C2; } else if (pn < 8) { base = KK; colt = (pn - 4) * 256; } else if (pn < 12) { base = VV; colt = (pn - 8) * 256; }
        else { base = GG; ldc = 2048; colt = (pn - 12) * 256; sig = true; }
        const int col0 = colt + wc * 32 + 8 * fq;
#pragma unroll
        for (int ai = 0; ai < 2; ++ai)
#pragma unroll
            for (int m = 0; m < 4; ++m) { bf16_t* rowp = base + (size_t)(row0 + ai * HALF + m * 16) * ldc + col0;
#pragma unroll
                for (int bj = 0; bj < 2; ++bj) { f32x4 v0 = acc[ai][bj][m][0], v1 = acc[ai][bj][m][1];
                    if (sig) {
#pragma unroll
                        for (int e = 0; e < 4; ++e) { v0[e] = sigmoidf_fast(v0[e]); v1[e] = sigmoidf_fast(v1[e]); } }
                    else { v0 = v0 * sc; v1 = v1 * sc; }
                    u32x4 w; w.x = cvt_pk_bf16(v0[0], v0[1]); w.y = cvt_pk_bf16(v0[2], v0[3]); w.z = cvt_pk_bf16(v1[0], v1[1]); w.w = cvt_pk_bf16(v1[2], v1[3]);
                    *(u32x4*)(rowp + bj * HALF) = w; } }
    }
};
struct EpiMergeK {
    static constexpr bool PERM = true, AFTER_DRAIN = false, MIDK = true;
    bf16_t* MG; const bf16_t* GG;
    __device__ __forceinline__ void mid(f32x4 (&acc)[2][2][4][2], const Unit& u, int wr, int wc, int fr, int fq) const {
        int row0 = u.pm * BM + wr * 64 + fr; int col0 = u.pn * BM + wc * 32 + 8 * fq;
        asm volatile("" : "+v"(row0), "+v"(col0));
#pragma unroll
        for (int ai = 0; ai < 2; ++ai)
#pragma unroll
            for (int m = 0; m < 4; ++m) { if ((m & 1) == 0) asm volatile("" ::: "memory"); const size_t r = (size_t)(row0 + ai * HALF + m * 16);
#pragma unroll
                for (int bj = 0; bj < 2; ++bj) { const int c = col0 + bj * HALF;
                    const u32x4 ga = *(const u32x4*)(GG + r * 2048 + c), gc = *(const u32x4*)(GG + r * 2048 + 1024 + c);
                    f32x4& v0 = acc[ai][bj][m][0]; f32x4& v1 = acc[ai][bj][m][1];
                    v0[0] *= bf_lo(ga.x) * __builtin_amdgcn_rcpf(bf_lo(gc.x)); v0[1] *= bf_hi(ga.x) * __builtin_amdgcn_rcpf(bf_hi(gc.x));
                    v0[2] *= bf_lo(ga.y) * __builtin_amdgcn_rcpf(bf_lo(gc.y)); v0[3] *= bf_hi(ga.y) * __builtin_amdgcn_rcpf(bf_hi(gc.y));
                    v1[0] *= bf_lo(ga.z) * __builtin_amdgcn_rcpf(bf_lo(gc.z)); v1[1] *= bf_hi(ga.z) * __builtin_amdgcn_rcpf(bf_hi(gc.z));
                    v1[2] *= bf_lo(ga.w) * __builtin_amdgcn_rcpf(bf_lo(gc.w)); v1[3] *= bf_hi(ga.w) * __builtin_amdgcn_rcpf(bf_hi(gc.w)); } }
    }
    __device__ __forceinline__ void operator()(const f32x4 (&acc)[2][2][4][2], const Unit& u, int wr, int wc, int fr, int fq) const {
        const int row0 = u.pm * BM + wr * 64 + fr; const int col0 = u.pn * BM + wc * 32 + 8 * fq;
#pragma unroll
        for (int ai = 0; ai < 2; ++ai)
#pragma unroll
            for (int m = 0; m < 4; ++m) { const size_t r = (size_t)(row0 + ai * HALF + m * 16);
#pragma unroll
                for (int bj = 0; bj < 2; ++bj) { const int c = col0 + bj * HALF;
                    const u32x4 gw = *(const u32x4*)(GG + r * 2048 + 1024 + c);
                    f32x4 v0 = acc[ai][bj][m][0], v1 = acc[ai][bj][m][1];
                    v0[0] *= bf_lo(gw.x); v0[1] *= bf_hi(gw.x); v0[2] *= bf_lo(gw.y); v0[3] *= bf_hi(gw.y);
                    v1[0] *= bf_lo(gw.z); v1[1] *= bf_hi(gw.z); v1[2] *= bf_lo(gw.w); v1[3] *= bf_hi(gw.w);
                    u32x4 w; w.x = cvt_pk_bf16(v0[0], v0[1]); w.y = cvt_pk_bf16(v0[2], v0[3]); w.z = cvt_pk_bf16(v1[0], v1[1]); w.w = cvt_pk_bf16(v1[2], v1[3]);
                    *(u32x4*)(MG + r * 1024 + c) = w; } }
    }
};
struct EpiF32 {
    static constexpr bool PERM = false, AFTER_DRAIN = false, MIDK = false;
    float* out; int ldc;
    __device__ __forceinline__ void operator()(const f32x4 (&acc)[2][2][4][2], const Unit& u, int wr, int wc, int fr, int fq) const {
        const int row0 = u.pm * BM + wr * 64 + fr; const int col0 = u.pn * BM + wc * 32 + 4 * fq;
#pragma unroll
        for (int ai = 0; ai < 2; ++ai)
#pragma unroll
            for (int m = 0; m < 4; ++m) { float* rowp = out + (size_t)(row0 + ai * HALF + m * 16) * ldc + col0;
#pragma unroll
                for (int bj = 0; bj < 2; ++bj)
#pragma unroll
                    for (int n = 0; n < 2; ++n) *(f32x4*)(rowp + bj * HALF + n * 16) = acc[ai][bj][m][n]; }
    }
};
#ifndef DPP_ROR1
#define DPP_ROR1 0x121
#define DPP_ROR2 0x122
#endif
template <int CTRL> __device__ __forceinline__ float dpp_ror(float v) { return __builtin_bit_cast(float, __builtin_amdgcn_update_dpp(0, __builtin_bit_cast(int, v), CTRL, 0xf, 0xf, false)); }
struct EpiBf16P {
    static constexpr bool PERM = true, AFTER_DRAIN = false, MIDK = false;
    bf16_t* out; int ldc;
    __device__ __forceinline__ void operator()(const f32x4 (&acc)[2][2][4][2], const Unit& u, int wr, int wc, int fr, int fq) const {
        const int row0 = u.pm * BM + wr * 64 + fr; const int col0 = u.pn * BM + wc * 32 + 8 * fq;
#pragma unroll
        for (int ai = 0; ai < 2; ++ai)
#pragma unroll
            for (int m = 0; m < 4; ++m) { bf16_t* rowp = out + (size_t)(row0 + ai * HALF + m * 16) * ldc + col0;
#pragma unroll
                for (int bj = 0; bj < 2; ++bj) { const f32x4 v0 = acc[ai][bj][m][0], v1 = acc[ai][bj][m][1];
                    u32x4 w; w.x = cvt_pk_bf16(v0[0], v0[1]); w.y = cvt_pk_bf16(v0[2], v0[3]); w.z = cvt_pk_bf16(v1[0], v1[1]); w.w = cvt_pk_bf16(v1[2], v1[3]);
                    *(u32x4*)(rowp + bj * HALF) = w; } }
    }
};
struct EpiUp {
    static constexpr bool PERM = true, AFTER_DRAIN = false, MIDK = false;
    bf16_t* GF; float* HD; float* TL; const float* cw; const float* cb;
    __device__ __forceinline__ void operator()(const f32x4 (&acc)[2][2][4][2], const Unit& u, int wr, int wc, int fr, int fq) const {
        const int lane = fq * 16 + fr;
        const int colA0 = u.pn * 128 + wc * 32 + 8 * fq;
#pragma unroll
        for (int n = 0; n < 2; ++n) {
            asm volatile("" ::: "memory");
            const int ca = colA0 + 4 * n;
            const f32x4 w0a = *(const f32x4*)(cw + ca), w1a = *(const f32x4*)(cw + 5632 + ca), w2a = *(const f32x4*)(cw + 2 * 5632 + ca), ba = *(const f32x4*)(cb + ca);
            const f32x4 w0v = *(const f32x4*)(cw + 2816 + ca), w1v = *(const f32x4*)(cw + 5632 + 2816 + ca), w2v = *(const f32x4*)(cw + 2 * 5632 + 2816 + ca), bv = *(const f32x4*)(cb + 2816 + ca);
#pragma unroll
            for (int ai = 0; ai < 2; ++ai) {
                const int rowg = u.pm * BM + ai * HALF + wr * 64; const int grp = rowg >> 6;
                f32x4 pa1 = (f32x4){0.f, 0.f, 0.f, 0.f}, pa2 = pa1, pv1 = pa1, pv2 = pa1;
#pragma unroll
                for (int m = 0; m < 4; ++m) {
                    const f32x4 ua = acc[ai][0][m][n], uv = acc[ai][1][m][n];
                    f32x4 ra1, ra2, rv1, rv2;
#pragma unroll
                    for (int e = 0; e < 4; ++e) { ra1[e] = dpp_ror<DPP_ROR1>(ua[e]); ra2[e] = dpp_ror<DPP_ROR2>(ua[e]); rv1[e] = dpp_ror<DPP_ROR1>(uv[e]); rv2[e] = dpp_ror<DPP_ROR2>(uv[e]); }
                    const f32x4 a1 = fr >= 1 ? ra1 : pa1, a2 = fr >= 2 ? ra2 : pa2, v1 = fr >= 1 ? rv1 : pv1, v2 = fr >= 2 ? rv2 : pv2;
                    const f32x4 ya = ba + w2a * ua + w1a * a1 + w0a * a2, yv = bv + w2v * uv + w1v * v1 + w0v * v2;
                    float g[4];
#pragma unroll
                    for (int e = 0; e < 4; ++e) g[e] = ya[e] * sigmoidf_fast(ya[e]) * yv[e];
                    u32x2 w; w.x = cvt_pk_bf16(g[0], g[1]); w.y = cvt_pk_bf16(g[2], g[3]);
                    *(u32x2*)(GF + (size_t)(rowg + m * 16 + fr) * 2816 + ca) = w;
                    if (m == 0 && fr < 2) { float* p = HD + (size_t)(grp * 2 + fr) * 5632 + ca; *(f32x4*)p = ua; *(f32x4*)(p + 2816) = uv; }
                    if (m == 3 && fr >= 14) { float* p = TL + (size_t)(grp * 2 + fr - 14) * 5632 + ca; *(f32x4*)p = ua; *(f32x4*)(p + 2816) = uv; }
                    pa1 = ra1; pa2 = ra2; pv1 = rv1; pv2 = rv2;
                }
            }
        }
    }
};

template <class Epi, class Sched, bool ALIGN_EPI = false, bool SP2 = false>
__device__ __forceinline__ void gemm_phase(PG8_LAS unsigned char* lds, const Gemm g, const Sched& S, const Epi& E) {
    int tid_ = threadIdx.x; asm volatile("" : "+v"(tid_)); const int tid = tid_, wid = __builtin_amdgcn_readfirstlane(tid >> 6), lane = tid & 63, wr = wid >> 2, wc = wid & 3, fr = lane & 15, fq = lane >> 4;
    const int K = g.K, nt = K / BK;
    unsigned voffA[2], voffB[2];
#pragma unroll
    for (int i = 0; i < 2; ++i) { int R, C; stage_rc(tid * 16 + i * 8192, R, C); const int Rb = Epi::PERM ? ((R & ~31) + perm32(R & 31)) : R;
        voffA[i] = (unsigned)(R * g.lda + C) * 2u; voffB[i] = (unsigned)(Rb * g.ldb + C) * 2u; }
    const size_t kstep = (size_t)(BK * 2);
    const size_t hstepA = (size_t)HALF * g.lda * 2, hstepB = (size_t)HALF * g.ldb * 2;
    const size_t tstepA = 2 * hstepA, tstepB = 2 * hstepB;
    const unsigned ldsw = (unsigned)wid * 1024u;
    const int aoff = lds_byte(wr * 64 + fr, fq * 8), boff = lds_byte(wc * 32 + fr, fq * 8);
#define PG8_SA(b, h) (((b) * 2 + (h)) * HTB)
#define PG8_SB(b, h) ((4 + (b) * 2 + (h)) * HTB)
#define PG8_STAGE(bufoff, gbase, voff) do { _Pragma("unroll") for (int _i = 0; _i < 2; ++_i) \
        __builtin_amdgcn_global_load_lds((const unsigned*)((const char*)(gbase) + (voff)[_i]), (PG8_LAS unsigned*)(lds + (bufoff) + ldsw + _i * 8192), 16, 0, 0); } while (0)
#define PG8_LDA(dst, b, h) do { _Pragma("unroll") for (int m = 0; m < 4; ++m) _Pragma("unroll") for (int k = 0; k < 2; ++k) dst[m][k] = *(const PG8_LAS bf16x8*)(lds + PG8_SA(b, h) + aoff + m * 2048 + k * 1024); } while (0)
#define PG8_LDB(dst, b, h) do { _Pragma("unroll") for (int n = 0; n < 2; ++n) _Pragma("unroll") for (int k = 0; k < 2; ++k) dst[n][k] = *(const PG8_LAS bf16x8*)(lds + PG8_SB(b, h) + boff + n * 2048 + k * 1024); } while (0)
#define PG8_MMA(ai, bj, At, Bt) do { __builtin_amdgcn_s_setprio(1); _Pragma("unroll") for (int m = 0; m < 4; ++m) _Pragma("unroll") for (int n = 0; n < 2; ++n) _Pragma("unroll") for (int k = 0; k < 2; ++k) \
        acc[ai][bj][m][n] = __builtin_amdgcn_mfma_f32_16x16x32_bf16(Bt[n][k], At[m][k], acc[ai][bj][m][n], 0, 0, 0); __builtin_amdgcn_s_setprio(0); } while (0)
#define PG8_WAIT_V(n) asm volatile("s_waitcnt vmcnt(" #n ")" ::: "memory")
#define PG8_WAIT_L(n) asm volatile("s_waitcnt lgkmcnt(" #n ")" ::: "memory")
#define PG8_BAR __builtin_amdgcn_s_barrier()
#define PG8_SCHED __builtin_amdgcn_sched_barrier(0)
    Unit cur, nxt; int ui = 0;
    if (!S.next(0, cur)) return;
    f32x4 acc[2][2][4][2];
#pragma unroll
    for (int a = 0; a < 2; ++a)
#pragma unroll
        for (int b = 0; b < 2; ++b)
#pragma unroll
            for (int m = 0; m < 4; ++m)
#pragma unroll
                for (int n = 0; n < 2; ++n) acc[a][b][m][n] = (f32x4){0.f, 0.f, 0.f, 0.f};
    bf16x8 At[4][2], B0[2][2], B1[2][2];
    const char* cA = (const char*)g.A + (size_t)cur.pm * tstepA; const char* cB = (const char*)g.Bt + (size_t)cur.pn * tstepB;
    S.a_ready(cur);
    if constexpr (SP2) {
        PG8_STAGE(PG8_SB(0, 0), cB, voffB); PG8_STAGE(PG8_SB(0, 1), cB + hstepB, voffB); PG8_STAGE(PG8_SA(0, 0), cA, voffA); PG8_STAGE(PG8_SA(0, 1), cA + hstepA, voffA);
        if (wr == 1) PG8_BAR;
        PG8_WAIT_V(2); PG8_BAR;
        PG8_STAGE(PG8_SB(1, 0), cB + kstep, voffB); PG8_STAGE(PG8_SA(1, 0), cA + kstep, voffA); PG8_STAGE(PG8_SB(1, 1), cB + hstepB + kstep, voffB);
        PG8_WAIT_V(6); PG8_BAR;
    } else {
        PG8_STAGE(PG8_SB(0, 0), cB, voffB); PG8_STAGE(PG8_SA(0, 0), cA, voffA); PG8_STAGE(PG8_SB(0, 1), cB + hstepB, voffB); PG8_STAGE(PG8_SA(0, 1), cA + hstepA, voffA);
        if (wr == 1) PG8_BAR;
        PG8_WAIT_V(4); PG8_BAR;
        PG8_STAGE(PG8_SB(1, 0), cB + kstep, voffB); PG8_STAGE(PG8_SA(1, 0), cA + kstep, voffA); PG8_STAGE(PG8_SB(1, 1), cB + hstepB + kstep, voffB);
        PG8_WAIT_V(6); PG8_BAR;
    }
    for (;;) {
        const bool has_next = S.next(ui + 1, nxt);
        const char* nA = has_next ? (const char*)g.A + (size_t)nxt.pm * tstepA : cA; const char* nB = has_next ? (const char*)g.Bt + (size_t)nxt.pn * tstepB : cB;
        for (int t = 0; t < nt; t += 2) {
            const bool last = (t == nt - 2);
            const char* a1 = cA + (size_t)(t + 1) * kstep;
            const char* a2 = last ? nA : cA + (size_t)(t + 2) * kstep; const char* b2 = last ? nB : cB + (size_t)(t + 2) * kstep;
            const char* a3 = a2 + kstep; const char* b3 = b2 + kstep;
            if (last && has_next) S.a_ready(nxt);
            if constexpr (Epi::MIDK) { if (t == (nt >> 1)) E.mid(acc, cur, wr, wc, fr, fq); }
            if constexpr (SP2) {
            PG8_LDB(B0, 0, 0); PG8_LDB(B1, 0, 1); PG8_SCHED; PG8_LDA(At, 0, 0); PG8_STAGE(PG8_SA(1, 1), a1 + hstepA, voffA);
            PG8_WAIT_V(8); PG8_WAIT_L(0); PG8_BAR; PG8_MMA(0, 0, At, B0); PG8_MMA(0, 1, At, B1); PG8_BAR; PG8_SCHED;
            PG8_LDA(At, 0, 1); PG8_STAGE(PG8_SB(0, 0), b2, voffB); PG8_STAGE(PG8_SB(0, 1), b2 + hstepB, voffB); PG8_STAGE(PG8_SA(0, 0), a2, voffA);
            PG8_WAIT_V(8); PG8_WAIT_L(0); PG8_BAR; PG8_MMA(1, 0, At, B0); PG8_MMA(1, 1, At, B1); PG8_BAR; PG8_SCHED;
            PG8_LDB(B0, 1, 0); PG8_LDB(B1, 1, 1); PG8_SCHED; PG8_LDA(At, 1, 0); PG8_STAGE(PG8_SA(0, 1), a2 + hstepA, voffA);
            PG8_WAIT_V(8); PG8_WAIT_L(0); PG8_BAR; PG8_MMA(0, 0, At, B0); PG8_MMA(0, 1, At, B1); PG8_BAR; PG8_SCHED;
            PG8_LDA(At, 1, 1); PG8_STAGE(PG8_SB(1, 0), b3, voffB); PG8_STAGE(PG8_SB(1, 1), b3 + hstepB, voffB); PG8_STAGE(PG8_SA(1, 0), a3, voffA);
            PG8_WAIT_V(8); PG8_WAIT_L(0); PG8_BAR; PG8_MMA(1, 0, At, B0); PG8_MMA(1, 1, At, B1); PG8_BAR; PG8_SCHED;
            } else {
            PG8_LDB(B0, 0, 0); PG8_SCHED; PG8_LDA(At, 0, 0); PG8_STAGE(PG8_SA(1, 1), a1 + hstepA, voffA);
            PG8_WAIT_L(8); PG8_BAR; PG8_WAIT_L(0); PG8_MMA(0, 0, At, B0); PG8_BAR; PG8_SCHED;
            PG8_LDB(B1, 0, 1); PG8_STAGE(PG8_SB(0, 0), b2, voffB);
            PG8_BAR; PG8_WAIT_L(0); PG8_MMA(0, 1, At, B1); PG8_BAR;
            PG8_LDA(At, 0, 1); PG8_STAGE(PG8_SA(0, 0), a2, voffA);
            PG8_BAR; PG8_WAIT_L(0); PG8_MMA(1, 0, At, B0); PG8_BAR; PG8_SCHED;
            PG8_STAGE(PG8_SB(0, 1), b2 + hstepB, voffB);
            PG8_WAIT_V(6); PG8_BAR; PG8_MMA(1, 1, At, B1); PG8_BAR;
            PG8_LDB(B0, 1, 0); PG8_SCHED; PG8_LDA(At, 1, 0); PG8_STAGE(PG8_SA(0, 1), a2 + hstepA, voffA);
            PG8_WAIT_L(8); PG8_BAR; PG8_WAIT_L(0); PG8_MMA(0, 0, At, B0); PG8_BAR; PG8_SCHED;
            PG8_LDB(B1, 1, 1); PG8_STAGE(PG8_SB(1, 0), b3, voffB);
            PG8_BAR; PG8_WAIT_L(0); PG8_MMA(0, 1, At, B1); PG8_BAR;
            PG8_LDA(At, 1, 1); PG8_STAGE(PG8_SA(1, 0), a3, voffA);
            PG8_BAR; PG8_WAIT_L(0); PG8_MMA(1, 0, At, B0); PG8_BAR; PG8_SCHED;
            PG8_STAGE(PG8_SB(1, 1), b3 + hstepB, voffB);
            PG8_WAIT_V(6); PG8_BAR; PG8_MMA(1, 1, At, B1); PG8_BAR;
            }
        }
        if constexpr (ALIGN_EPI) { if (wr == 0) PG8_BAR; }
        if constexpr (!Epi::AFTER_DRAIN) { E(acc, cur, wr, wc, fr, fq); S.done(cur); }
        if (!has_next) break;
#pragma unroll
        for (int a = 0; a < 2; ++a)
#pragma unroll
            for (int b = 0; b < 2; ++b)
#pragma unroll
                for (int m = 0; m < 4; ++m)
#pragma unroll
                    for (int n = 0; n < 2; ++n) acc[a][b][m][n] = (f32x4){0.f, 0.f, 0.f, 0.f};
        cur = nxt; cA = nA; cB = nB; ++ui;
        if constexpr (ALIGN_EPI) { if (wr == 1) PG8_BAR; }
    }
    PG8_WAIT_V(0);
    if constexpr (!ALIGN_EPI) { if (wr == 0) PG8_BAR; }
    PG8_BAR;
    if constexpr (Epi::AFTER_DRAIN) { E.fused(acc, cur, wr, wc, fr, fq, lds, wid, lane); S.done(cur); }
#undef PG8_SA
#undef PG8_SB
#undef PG8_STAGE
#undef PG8_LDA
#undef PG8_LDB
#undef PG8_MMA
#undef PG8_WAIT_V
#undef PG8_WAIT_L
#undef PG8_BAR
#undef PG8_SCHED
}
constexpr int SG_PITCH = 144, SG_TILE = 256 * SG_PITCH, SG_LDS = 4 * SG_TILE;
template <class Epi, class Sched>
__device__ __forceinline__ void sgemm_phase(PG8_LAS unsigned char* lds, const Gemm g, const Sched& S, const Epi& E) {
    int tid_ = threadIdx.x; asm volatile("" : "+v"(tid_)); const int tid = tid_, wid = __builtin_amdgcn_readfirstlane(tid >> 6), lane = tid & 63, wr = wid >> 2, wc = wid & 3, fr = lane & 15, fq = lane >> 4;
    const int nt = g.K / BK;
    const int srow = tid >> 3, schunk = tid & 7;
    const unsigned sl = (unsigned)(srow * SG_PITCH + schunk * 16);
    const unsigned aoff = (unsigned)((wr * 64 + fr) * SG_PITCH + fq * 16);
    const int brow = Epi::PERM ? (8 * (fr >> 2) + (fr & 3)) : fr;
    const unsigned boff = (unsigned)((wc * 32 + brow) * SG_PITCH + fq * 16);
    Unit cur;
    for (int ui = 0; S.next(ui, cur); ++ui) {
        f32x4 acc[2][2][4][2];
#pragma unroll
        for (int a = 0; a < 2; ++a)
#pragma unroll
            for (int b = 0; b < 2; ++b)
#pragma unroll
                for (int m = 0; m < 4; ++m)
#pragma unroll
                    for (int n = 0; n < 2; ++n) acc[a][b][m][n] = (f32x4){0.f, 0.f, 0.f, 0.f};
        const bf16_t* gA = g.A + (size_t)(cur.pm * BM + srow) * g.lda + schunk * 8;
        const bf16_t* gB = g.Bt + (size_t)(cur.pn * BM + srow) * g.ldb + schunk * 8;
        u32x4 ra[4], rb[4];
#pragma unroll
        for (int p = 0; p < 4; ++p) { ra[p] = *(const u32x4*)(gA + (size_t)p * 64 * g.lda); rb[p] = *(const u32x4*)(gB + (size_t)p * 64 * g.ldb); }
#pragma unroll
        for (int p = 0; p < 4; ++p) { *(PG8_LAS u32x4*)(lds + sl + p * 64 * SG_PITCH) = ra[p]; *(PG8_LAS u32x4*)(lds + 2 * SG_TILE + sl + p * 64 * SG_PITCH) = rb[p]; }
        __syncthreads();
        for (int t = 0; t < nt; ++t) {
            const int buf = t & 1;
            if constexpr (Epi::MIDK) { if (t == (nt >> 1)) E.mid(acc, cur, wr, wc, fr, fq); }
            if (t + 1 < nt) {
#pragma unroll
                for (int p = 0; p < 4; ++p) { ra[p] = *(const u32x4*)(gA + (size_t)p * 64 * g.lda + (t + 1) * BK); rb[p] = *(const u32x4*)(gB + (size_t)p * 64 * g.ldb + (t + 1) * BK); }
            }
            PG8_LAS unsigned char* la = lds + buf * SG_TILE; PG8_LAS unsigned char* lb = lds + 2 * SG_TILE + buf * SG_TILE;
#pragma unroll
            for (int k = 0; k < 2; ++k) {
                bf16x8 Bf[2][2], Af[2][4];
#pragma unroll
                for (int bj = 0; bj < 2; ++bj)
#pragma unroll
                    for (int n = 0; n < 2; ++n) Bf[bj][n] = *(const PG8_LAS bf16x8*)(lb + boff + (bj * 128 + (Epi::PERM ? 4 * n : 16 * n)) * SG_PITCH + k * 64);
#pragma unroll
                for (int ai = 0; ai < 2; ++ai)
#pragma unroll
                    for (int m = 0; m < 4; ++m) Af[ai][m] = *(const PG8_LAS bf16x8*)(la + aoff + (ai * 128 + m * 16) * SG_PITCH + k * 64);
#pragma unroll
                for (int ai = 0; ai < 2; ++ai)
#pragma unroll
                    for (int bj = 0; bj < 2; ++bj)
#pragma unroll
                        for (int m = 0; m < 4; ++m)
#pragma unroll
                            for (int n = 0; n < 2; ++n) acc[ai][bj][m][n] = __builtin_amdgcn_mfma_f32_16x16x32_bf16(Bf[bj][n], Af[ai][m], acc[ai][bj][m][n], 0, 0, 0);
            }
            if (t + 1 < nt) {
                const int nb = buf ^ 1;
#pragma unroll
                for (int p = 0; p < 4; ++p) { *(PG8_LAS u32x4*)(lds + nb * SG_TILE + sl + p * 64 * SG_PITCH) = ra[p]; *(PG8_LAS u32x4*)(lds + 2 * SG_TILE + nb * SG_TILE + sl + p * 64 * SG_PITCH) = rb[p]; }
            }
            __syncthreads();
        }
        E(acc, cur, wr, wc, fr, fq);
    }
}
}

#define LAS __attribute__((address_space(3)))
typedef unsigned short bf16;
typedef float f32x4 __attribute__((ext_vector_type(4)));
typedef float f32x16 __attribute__((ext_vector_type(16)));
typedef short bf16x8 __attribute__((ext_vector_type(8)));
typedef short s16x4 __attribute__((ext_vector_type(4)));
typedef unsigned u32x4 __attribute__((ext_vector_type(4)));
typedef unsigned u32x2 __attribute__((ext_vector_type(2)));

constexpr int BATCH = 4, SEQ = 8192, DM = 1024, T = BATCH * SEQ, NL = 2, DFF = 2816, NUP = 5632, PROJ = 5128, NPROJ = 5120, NMOD = 6144;
constexpr float LN_EPS = 1e-5f, ALPHA = 1.41421356237309515f, LOG2E = 1.4426950408889634f;
constexpr size_t MiB = 1u << 20;
constexpr size_t WS_MOD = 1 * MiB, WS_LF = 2 * MiB, WS_FL2 = 3 * MiB;
constexpr size_t WS_WIN = 4 * MiB, WS_WBR = 24 * MiB, WS_WOUT = 28 * MiB, WS_WUP = 32 * MiB, WS_WDN = 54 * MiB;
constexpr size_t WS_H = 66 * MiB, WS_QQ = 130 * MiB, WS_K = 194 * MiB, WS_V = 258 * MiB, WS_G = 322 * MiB;
constexpr size_t WS_MIX = 194 * MiB, WS_GFF = 130 * MiB, WS_HD = 322 * MiB, WS_TL = 344 * MiB, WS_Y = 322 * MiB, WS_END = 450 * MiB;
constexpr int LDS_BYTES = 147456 + 1024;
constexpr int NWAVES = 8;

struct Args {
    const float *x, *c, *w_in, *b_f, *rel_bias, *w_br_fox, *w_br_chunk, *w_out, *w_up, *conv_w, *conv_b, *w_down, *w_ada, *b_ada, *ln1_g, *ln1_b, *ln2_g, *ln2_b;
    float* out; unsigned char* ws;
    int phm, pad;
};

__device__ __forceinline__ unsigned f2bf(float f) { unsigned u = __builtin_bit_cast(unsigned, f); return (u + 0x7fffu + ((u >> 16) & 1u)) >> 16; }
__device__ __forceinline__ unsigned pk2(float lo, float hi) { return f2bf(lo) | (f2bf(hi) << 16); }
template <int CTRL> __device__ __forceinline__ float dpp_rot(float v) { return __builtin_bit_cast(float, __builtin_amdgcn_update_dpp(0, __builtin_bit_cast(int, v), CTRL, 0xf, 0xf, false)); }
__device__ __forceinline__ float wave_sum(float v) {
    v += dpp_rot<0x128>(v); v += dpp_rot<0x124>(v); v += dpp_rot<0x122>(v); v += dpp_rot<0x121>(v);
    v += __shfl_xor(v, 16);
    { const auto rr = __builtin_amdgcn_permlane32_swap(__float_as_uint(v), __float_as_uint(v), false, false); v = __uint_as_float(rr[0]) + __uint_as_float(rr[1]); }
    return v;
}

__device__ __forceinline__ int opq_v(int t) { asm volatile("" : "+v"(t)); return t; }
__device__ __forceinline__ int opq_s(int t) { asm volatile("" : "+s"(t)); return t; }

__device__ __forceinline__ void mod_phase(const Args& a, LAS unsigned char* lds, int G) {
    LAS float* condL = (LAS float*)lds;
    LAS float* red = (LAS float*)(lds + 16384);
    const int tid = opq_v((int)threadIdx.x);
    float* mod = (float*)(a.ws + WS_MOD);
    for (int i = tid; i < BATCH * DM; i += 512) { const float c = a.c[i]; condL[i] = c / (1.0f + __expf(-c)); }
    __syncthreads();
    for (int u = blockIdx.x; u < NL * (NMOD / 64); u += G) {
        const int l = u / (NMOD / 64), j0 = (u % (NMOD / 64)) * 64, col = tid & 63, kg = tid >> 6;
        float acc[BATCH] = {0.f, 0.f, 0.f, 0.f};
        const float* wp = a.w_ada + ((size_t)l * DM + kg * 128) * NMOD + j0 + col;
#pragma unroll 8
        for (int k = 0; k < 128; ++k) { const float w = wp[(size_t)k * NMOD];
#pragma unroll
            for (int b = 0; b < BATCH; ++b) acc[b] += condL[b * DM + kg * 128 + k] * w; }
#pragma unroll
        for (int b = 0; b < BATCH; ++b) red[(kg * 4 + b) * 64 + col] = acc[b];
        __syncthreads();
        if (tid < 256) { const int b = tid >> 6; float s = a.b_ada[l * NMOD + j0 + col];
#pragma unroll
            for (int g = 0; g < 8; ++g) s += red[(g * 4 + b) * 64 + col];
            mod[((size_t)l * BATCH + b) * NMOD + j0 + col] = s; }
        __syncthreads();
    }
}

__device__ __forceinline__ void tr_item(const float* W, int Nsrc, int k0, int n0s, bf16* WT, int ldk, int drow0, int koff, LAS float* scr, int lane) {
#pragma unroll 8
    for (int i = 0; i < 32; ++i) { const int kk = 2 * i + (lane >> 5); scr[kk * 33 + (lane & 31)] = W[(size_t)(k0 + kk) * Nsrc + n0s + (lane & 31)]; }
    asm volatile("s_waitcnt lgkmcnt(0)" ::: "memory");
    const int c = lane & 7;
#pragma unroll
    for (int j = 0; j < 4; ++j) { const int n = (lane >> 3) + 8 * j; const LAS float* s = scr + (8 * c) * 33 + n;
        u32x4 o; o.x = pk2(s[0 * 33], s[1 * 33]); o.y = pk2(s[2 * 33], s[3 * 33]); o.z = pk2(s[4 * 33], s[5 * 33]); o.w = pk2(s[6 * 33], s[7 * 33]);
        *(u32x4*)(WT + (size_t)(drow0 + n) * ldk + koff + k0 + 8 * c) = o; }
    asm volatile("s_waitcnt lgkmcnt(0)" ::: "memory");
}
__device__ __forceinline__ void weights_phase(const Args& a, LAS unsigned char* lds, int G) {
    const int tid = opq_v((int)threadIdx.x); const int lane = tid & 63, wave = tid >> 6;
    LAS float* scr = (LAS float*)(lds + 32768 + wave * 8704);
    const int gw = blockIdx.x * NWAVES + wave, NGW = G * NWAVES;
    constexpr int I_IN = 16 * 160, I_BR = 8 * 32, I_OUT = 16 * 32, I_UP = 16 * 176, I_DN = 44 * 32, I_L = I_IN + 2 * I_BR + I_OUT + I_UP + I_DN;
    for (int it = gw; it < NL * I_L; it += NGW) {
        const int l = it / I_L; int r = it % I_L;
        if (r < I_IN) { const int kb = r / 160, nb = r % 160, d = nb * 32, seg = d >> 9;
            const int segsrc = seg == 0 ? 0 : seg == 1 ? 1544 : seg == 2 ? 512 : seg == 3 ? 2056 : seg == 4 ? 1024 : seg == 5 ? 2568 : 3080 + (seg - 6) * 512;
            tr_item(a.w_in + (size_t)l * DM * PROJ, PROJ, kb * 64, segsrc + (d & 511), (bf16*)(a.ws + WS_WIN) + (size_t)l * NPROJ * DM, DM, d, 0, scr, lane); continue; }
        r -= I_IN;
        if (r < I_BR) { const int kb = r / 32, nb = r % 32; tr_item(a.w_br_fox + (size_t)l * 512 * DM, DM, kb * 64, nb * 32, (bf16*)(a.ws + WS_WBR) + (size_t)l * DM * DM, DM, nb * 32, 0, scr, lane); continue; }
        r -= I_BR;
        if (r < I_BR) { const int kb = r / 32, nb = r % 32; tr_item(a.w_br_chunk + (size_t)l * 512 * DM, DM, kb * 64, nb * 32, (bf16*)(a.ws + WS_WBR) + (size_t)l * DM * DM, DM, nb * 32, 512, scr, lane); continue; }
        r -= I_BR;
        if (r < I_OUT) { const int kb = r / 32, nb = r % 32; tr_item(a.w_out + (size_t)l * DM * DM, DM, kb * 64, nb * 32, (bf16*)(a.ws + WS_WOUT) + (size_t)l * DM * DM, DM, nb * 32, 0, scr, lane); continue; }
        r -= I_OUT;
        if (r < I_UP) { const int kb = r / 176, nb = r % 176, d = nb * 32, pn = d >> 8, bj = (d >> 7) & 1, j = d & 127;
            tr_item(a.w_up + (size_t)l * DM * NUP, NUP, kb * 64, bj * DFF + 128 * pn + j, (bf16*)(a.ws + WS_WUP) + (size_t)l * NUP * DM, DM, d, 0, scr, lane); continue; }
        r -= I_UP;
        { const int kb = r / 32, nb = r % 32; tr_item(a.w_down + (size_t)l * DFF * DM, DM, kb * 64, nb * 32, (bf16*)(a.ws + WS_WDN) + (size_t)l * DM * DFF, DFF, nb * 32, 0, scr, lane); }
    }
}

struct V16 { f32x4 v[4]; };
__device__ __forceinline__ V16 ldv(const float* p, int lane) { V16 r;
#pragma unroll
    for (int j = 0; j < 4; ++j) r.v[j] = *(const f32x4*)(p + 256 * j + 4 * lane);
    return r; }
__device__ __forceinline__ void ln_stats(const V16& x, float& mean, float& rstd) {
    float s = 0.f;
#pragma unroll
    for (int j = 0; j < 4; ++j) s += (x.v[j][0] + x.v[j][1]) + (x.v[j][2] + x.v[j][3]);
    mean = wave_sum(s) * (1.f / DM); float q = 0.f;
#pragma unroll
    for (int j = 0; j < 4; ++j) { const f32x4 d = x.v[j] - mean; q += (d[0] * d[0] + d[1] * d[1]) + (d[2] * d[2] + d[3] * d[3]); }
    rstd = 1.f / sqrtf(wave_sum(q) * (1.f / DM) + LN_EPS);
}
template <bool RES, bool HOUT, bool FOUT>
__device__ __forceinline__ void ln_pass(const Args& a, LAS unsigned char* lds, int G, const float* xin, const bf16* add, float* xout,
                                        const float* mod_gate  , const float* lg, const float* lb,
                                        const float* mod_sc, const float* mod_sh, int f_layer) {
    const int tid = opq_v((int)threadIdx.x), lane = tid & 63, wave = tid >> 6;
    LAS float* wfL = (LAS float*)lds;
    if (FOUT) {
        for (int i = tid; i < 2048; i += 512) { const int k = i >> 1, hf = i & 1;
            const f32x4 w = *(const f32x4*)(a.w_in + ((size_t)f_layer * DM + k) * PROJ + 1536 + hf * 4);
#pragma unroll
            for (int e = 0; e < 4; ++e) wfL[(hf * 4 + e) * DM + k] = w[e]; }
        __syncthreads();
    }
    const int gw = blockIdx.x * NWAVES + wave, NGW = G * NWAVES;
    const int rpw = (T + NGW - 1) / NGW; const int r0 = gw * rpw, r1 = (r0 + rpw < T) ? r0 + rpw : T;
    bf16* hout = (bf16*)(a.ws + WS_H); float* lf = (float*)(a.ws + WS_LF);
    V16 xnext; u32x2 ynext[4];
    if (r0 < r1) { xnext = ldv(xin + (size_t)r0 * DM, lane);
        if (RES) {
#pragma unroll
            for (int j = 0; j < 4; ++j) ynext[j] = *(const u32x2*)(add + (size_t)r0 * DM + 256 * j + 4 * lane); } }
    for (int row = r0; row < r1; ++row) {
        const int b = row / SEQ;
        const float *pg = mod_gate, *plg = lg, *plb = lb, *psc = mod_sc, *psh = mod_sh;
        asm volatile("" : "+s"(pg), "+s"(plg), "+s"(plb), "+s"(psc), "+s"(psh));
        V16 x = xnext; float mean, rstd; u32x2 ycur[4];
        if (RES) {
#pragma unroll
            for (int j = 0; j < 4; ++j) ycur[j] = ynext[j]; }
        if (row + 1 < r1) { xnext = ldv(xin + (size_t)(row + 1) * DM, lane);
            if (RES) {
#pragma unroll
                for (int j = 0; j < 4; ++j) ynext[j] = *(const u32x2*)(add + (size_t)(row + 1) * DM + 256 * j + 4 * lane); } }
        if (RES) { { V16 y;
#pragma unroll
            for (int j = 0; j < 4; ++j) { const u32x2 w = ycur[j]; y.v[j][0] = __uint_as_float(w.x << 16); y.v[j][1] = __uint_as_float(w.x & 0xffff0000u); y.v[j][2] = __uint_as_float(w.y << 16); y.v[j][3] = __uint_as_float(w.y & 0xffff0000u); }
            const V16 vg = ldv(pg + (size_t)b * NMOD, lane);
#pragma unroll
            for (int j = 0; j < 4; ++j) x.v[j] = ALPHA * x.v[j] + (1.0f + vg.v[j]) * y.v[j]; }
            ln_stats(x, mean, rstd);
            { const V16 vlg = ldv(plg, lane), vlb = ldv(plb, lane);
#pragma unroll
            for (int j = 0; j < 4; ++j) { x.v[j] = (x.v[j] - mean) * rstd * vlg.v[j] + vlb.v[j]; *(f32x4*)(xout + (size_t)row * DM + 256 * j + 4 * lane) = x.v[j]; } } }
        if (HOUT) {
            ln_stats(x, mean, rstd);
            { const V16 vsc = ldv(psc + (size_t)b * NMOD, lane), vsh = ldv(psh + (size_t)b * NMOD, lane);
#pragma unroll
            for (int j = 0; j < 4; ++j) { x.v[j] = (x.v[j] - mean) * rstd * (1.0f + vsc.v[j]) + vsh.v[j];
                u32x2 w; w.x = pk2(x.v[j][0], x.v[j][1]); w.y = pk2(x.v[j][2], x.v[j][3]); *(u32x2*)(hout + (size_t)row * DM + 256 * j + 4 * lane) = w; } }
            if (FOUT) { float myf = 0.f;
#pragma unroll 2
                for (int hh = 0; hh < 8; ++hh) { float s = 0.f;
#pragma unroll
                    for (int j = 0; j < 4; ++j) { const f32x4 w = *(const LAS f32x4*)(wfL + hh * DM + 256 * j + 4 * lane); s += (x.v[j][0] * w[0] + x.v[j][1] * w[1]) + (x.v[j][2] * w[2] + x.v[j][3] * w[3]); }
                    s = wave_sum(s); if (lane == hh) myf = s; }
                if (lane < 8) { const float z = myf + a.b_f[f_layer * 8 + lane];
                    const float ez = __expf(-fabsf(z)); const float l1p = (ez < 1e-4f) ? ez * (1.0f - 0.5f * ez) : __logf(1.0f + ez);
                    const float ls = fminf(z, 0.f) - l1p;
                    lf[(size_t)row * 8 + lane] = ls; } }
        }
    }
}

__device__ __forceinline__ void scan_phase(const Args& a, LAS unsigned char* lds, int G) {
    const int tid = opq_v((int)threadIdx.x), lane = tid & 63, wave = tid >> 6;
    LAS double* ws = (LAS double*)lds;
    const float* lf = (const float*)(a.ws + WS_LF); float* fl2 = (float*)(a.ws + WS_FL2);
    for (int sq = blockIdx.x; sq < BATCH * 8; sq += G) {
        const int b = sq >> 3, hh = sq & 7;
        float v[16]; double s = 0.0;
#pragma unroll
        for (int i = 0; i < 16; ++i) { v[i] = lf[((size_t)b * SEQ + tid * 16 + i) * 8 + hh]; s += (double)v[i]; }
        double inc = s;
#pragma unroll
        for (int o = 1; o < 64; o <<= 1) { const double n = __shfl_up(inc, o); if (lane >= o) inc += n; }
        if (lane == 63) ws[wave] = inc;
        __syncthreads();
        double base = inc - s;
        for (int w = 0; w < wave; ++w) base += ws[w];
        double run = base;
#pragma unroll
        for (int i = 0; i < 16; ++i) { run += (double)v[i]; fl2[((size_t)b * 8 + hh) * SEQ + tid * 16 + i] = (float)(run * (double)LOG2E); }
        __syncthreads();
    }
}

__device__ __forceinline__ int crow(int r, int hi) { return (r & 3) + 8 * (r >> 2) + 4 * hi; }
constexpr int AL_K = 0, AL_VT = 16384, AL_FB = 16384 + 2 * 8704, AL_EXT = AL_FB + 512, VT_STRIDE = 136, AL_MISC = 36864;
constexpr size_t WS_KN = 800 * 1024;
template <int MODE>
__device__ __forceinline__ void attn_unit(const bf16* QQ, const bf16* KK, const bf16* VV, bf16* OO, const float* fl2, const float* relb, int b, int h, int qb, LAS unsigned char* lds, float kmax2 = 0.f) {
    const int tid = opq_v((int)threadIdx.x), lane = tid & 63, r32 = lane & 31, hi = lane >> 5, wid = __builtin_amdgcn_readfirstlane(tid >> 6);
    const int hc = (MODE == 0 ? 0 : 512) + h * 64;
    const size_t rowbase = (size_t)b * SEQ; const int q0 = qb * 256;
    int kc0, NT;
    if (MODE == 0) { kc0 = 0; NT = 4 * (qb + 1); } else { kc0 = 4 * qb - 8 < 0 ? 0 : 4 * qb - 8; NT = 4 * qb + 4 - kc0; }
    if (MODE == 0) {
        float qn = 0.f;
        { const bf16* Qn = QQ + (rowbase + q0 + (tid >> 1)) * DM + hc + (tid & 1) * 32;
#pragma unroll
          for (int c = 0; c < 4; ++c) { const u32x4 v = *(const u32x4*)(Qn + c * 8);
              { const float lo = __uint_as_float(v.x << 16), hh = __uint_as_float(v.x & 0xffff0000u); qn += lo * lo + hh * hh; }
              { const float lo = __uint_as_float(v.y << 16), hh = __uint_as_float(v.y & 0xffff0000u); qn += lo * lo + hh * hh; }
              { const float lo = __uint_as_float(v.z << 16), hh = __uint_as_float(v.z & 0xffff0000u); qn += lo * lo + hh * hh; }
              { const float lo = __uint_as_float(v.w << 16), hh = __uint_as_float(v.w & 0xffff0000u); qn += lo * lo + hh * hh; } } }
        qn += __shfl_xor(qn, 1);
#pragma unroll
        for (int o = 32; o >= 2; o >>= 1) qn = fmaxf(qn, __shfl_xor(qn, o));
        LAS float* red = (LAS float*)(lds + AL_MISC); LAS int* t0s = (LAS int*)(lds + AL_MISC + 64);
        if (lane == 0) red[wid] = qn;
        if (tid == 0) *t0s = 4 * qb;
        __syncthreads();
        float q2 = red[0];
#pragma unroll
        for (int w = 1; w < 8; ++w) q2 = fmaxf(q2, red[w]);
        const float thr = 152.0f + 2.002f * sqrtf(q2 * kmax2);
        const float* fl = fl2 + ((size_t)b * 8 + h) * SEQ; const float fq0 = fl[q0];
        if (tid < 4 * qb) { if (fl[64 * tid + 63] - fq0 <= thr) atomicMin((int*)t0s, tid); }
        __syncthreads();
        kc0 = __builtin_amdgcn_readfirstlane(*t0s); NT = 4 * (qb + 1) - kc0;
    }
    const bf16* Qw = QQ + (rowbase + q0 + wid * 32 + r32) * DM + hc;
    bf16x8 qr[4];
#pragma unroll
    for (int d0 = 0; d0 < 4; ++d0) qr[d0] = *(const bf16x8*)(Qw + d0 * 16 + hi * 8);
    const int myc = 4 * qb + (wid >> 1);
    if (MODE == 1) {
        LAS float* rev = (LAS float*)(lds + AL_EXT);
        for (int i = tid; i < 639; i += 512) { int d = 575 - i; d = d > 128 ? 128 : d; rev[i] = LOG2E * relb[h * 257 + d + 128]; }
    }
    const int kvr = tid & 63, ch = tid >> 6;
    const bf16* gK = KK + (rowbase + (size_t)kc0 * 64 + kvr) * DM + hc + ch * 8;
    const bf16* gV = VV + (rowbase + (size_t)kc0 * 64 + kvr) * DM + hc + ch * 8;
    const float* gF = fl2 + ((size_t)b * 8 + h) * SEQ + kc0 * 64 + (tid & 63);
    u32x4 kreg = *(const u32x4*)gK, vreg = *(const u32x4*)gV; float freg = 0.f;
    if (MODE == 0 && tid < 64) freg = *gF;
    float m_run = -1e30f, l_run = 0.f; f32x16 ot0 = {}, ot1 = {};
    const int qabs = q0 + wid * 32 + r32;
    for (int t = 0; t < NT; ++t) {
        const int buf = t & 1;
        {
            *(LAS u32x4*)(lds + AL_K + buf * 8192 + (ch * 64 + kvr) * 16) = kreg;
            LAS unsigned short* vt = (LAS unsigned short*)(lds + AL_VT + buf * 8704) + (ch * 8) * (VT_STRIDE / 2) + kvr;
            vt[0 * 68] = (unsigned short)(vreg.x & 0xffff); vt[1 * 68] = (unsigned short)(vreg.x >> 16);
            vt[2 * 68] = (unsigned short)(vreg.y & 0xffff); vt[3 * 68] = (unsigned short)(vreg.y >> 16);
            vt[4 * 68] = (unsigned short)(vreg.z & 0xffff); vt[5 * 68] = (unsigned short)(vreg.z >> 16);
            vt[6 * 68] = (unsigned short)(vreg.w & 0xffff); vt[7 * 68] = (unsigned short)(vreg.w >> 16);
            if (MODE == 0 && tid < 64) *(LAS float*)(lds + AL_FB + buf * 256 + tid * 4) = freg;
        }
        __syncthreads();
        if (t + 1 < NT) { kreg = *(const u32x4*)(gK + (size_t)(t + 1) * 64 * DM); vreg = *(const u32x4*)(gV + (size_t)(t + 1) * 64 * DM); if (MODE == 0 && tid < 64) freg = gF[(t + 1) * 64]; }
        const int kv0 = (kc0 + t) * 64;
        bool part;
        if (MODE == 0) part = kv0 <= q0 + wid * 32 + 31; else { const int kc = kc0 + t; part = (kc <= myc) && (kc >= myc - 8); }
        if (part) {
            f32x16 p0 = {}, p1 = {};
            const LAS unsigned char* kbp = lds + AL_K + buf * 8192 + hi * 1024 + r32 * 16;
#pragma unroll
            for (int d0 = 0; d0 < 4; ++d0) {
                const bf16x8 a0 = *(const LAS bf16x8*)(kbp + d0 * 2048), a1 = *(const LAS bf16x8*)(kbp + d0 * 2048 + 512);
                p0 = __builtin_amdgcn_mfma_f32_32x32x16_bf16(a0, qr[d0], p0, 0, 0, 0);
                p1 = __builtin_amdgcn_mfma_f32_32x32x16_bf16(a1, qr[d0], p1, 0, 0, 0);
            }
            if (MODE == 0) {
                const LAS float* fb = (const LAS float*)(lds + AL_FB + buf * 256);
#pragma unroll
                for (int g = 0; g < 4; ++g) { const f32x4 f0 = *(const LAS f32x4*)(fb + 8 * g + 4 * hi), f1 = *(const LAS f32x4*)(fb + 32 + 8 * g + 4 * hi);
#pragma unroll
                    for (int e = 0; e < 4; ++e) { p0[4 * g + e] -= f0[e]; p1[4 * g + e] -= f1[e]; } }
                if (kv0 + 63 > q0 + wid * 32) {
#pragma unroll
                    for (int r = 0; r < 16; ++r) { const int kv = kv0 + crow(r, hi); if (kv > qabs) p0[r] = -1e30f; if (kv + 32 > qabs) p1[r] = -1e30f; }
                }
            } else {
                const LAS float* rv = (const LAS float*)(lds + AL_EXT) + (575 - (qabs - kv0) + 4 * hi);
#pragma unroll
                for (int r = 0; r < 16; ++r) { const int C = (r & 3) + 8 * (r >> 2); p0[r] += rv[C]; p1[r] += rv[C + 32]; }
            }
            float mx = p0[0];
#pragma unroll
            for (int r = 1; r < 16; ++r) mx = fmaxf(mx, p0[r]);
#pragma unroll
            for (int r = 0; r < 16; ++r) mx = fmaxf(mx, p1[r]);
            { const auto rr = __builtin_amdgcn_permlane32_swap(__float_as_uint(mx), __float_as_uint(mx), false, false); mx = fmaxf(__uint_as_float(rr[0]), __uint_as_float(rr[1])); }
            const float mnew = fmaxf(m_run, mx), sc = __builtin_amdgcn_exp2f(m_run - mnew); m_run = mnew;
            float rs = 0.f;
#pragma unroll
            for (int r = 0; r < 16; ++r) { p0[r] = __builtin_amdgcn_exp2f(p0[r] - mnew); p1[r] = __builtin_amdgcn_exp2f(p1[r] - mnew); rs += p0[r] + p1[r]; }
            l_run = l_run * sc + rs;
#pragma unroll
            for (int r = 0; r < 16; ++r) { ot0[r] *= sc; ot1[r] *= sc; }
            bf16x8 pa[4];
#pragma unroll
            for (int s = 0; s < 4; ++s) { u32x4 w;
                if (s < 2) { w.x = pg8::cvt_pk_bf16(p0[8 * s + 0], p0[8 * s + 1]); w.y = pg8::cvt_pk_bf16(p0[8 * s + 2], p0[8 * s + 3]); w.z = pg8::cvt_pk_bf16(p0[8 * s + 4], p0[8 * s + 5]); w.w = pg8::cvt_pk_bf16(p0[8 * s + 6], p0[8 * s + 7]); }
                else { const int q = 8 * (s - 2); w.x = pg8::cvt_pk_bf16(p1[q + 0], p1[q + 1]); w.y = pg8::cvt_pk_bf16(p1[q + 2], p1[q + 3]); w.z = pg8::cvt_pk_bf16(p1[q + 4], p1[q + 5]); w.w = pg8::cvt_pk_bf16(p1[q + 6], p1[q + 7]); }
                pa[s] = __builtin_bit_cast(bf16x8, w); }
            const LAS unsigned char* vtb = lds + AL_VT + buf * 8704 + r32 * VT_STRIDE + hi * 8;
#pragma unroll
            for (int s = 0; s < 4; ++s) {
                const u32x2 a_lo = *(const LAS u32x2*)(vtb + s * 32), a_hi = *(const LAS u32x2*)(vtb + s * 32 + 16);
                const u32x2 b_lo = *(const LAS u32x2*)(vtb + 32 * VT_STRIDE + s * 32), b_hi = *(const LAS u32x2*)(vtb + 32 * VT_STRIDE + s * 32 + 16);
                const bf16x8 va = __builtin_bit_cast(bf16x8, (u32x4){a_lo.x, a_lo.y, a_hi.x, a_hi.y}), vb = __builtin_bit_cast(bf16x8, (u32x4){b_lo.x, b_lo.y, b_hi.x, b_hi.y});
                ot0 = __builtin_amdgcn_mfma_f32_32x32x16_bf16(va, pa[s], ot0, 0, 0, 0);
                ot1 = __builtin_amdgcn_mfma_f32_32x32x16_bf16(vb, pa[s], ot1, 0, 0, 0);
            }
        }
    }
    l_run += __shfl_xor(l_run, 32);
    const float inv = 1.0f / l_run;
    bf16* Ow = OO + (rowbase + q0 + wid * 32 + r32) * DM + hc;
#pragma unroll
    for (int g = 0; g < 4; ++g) {
        u32x2 w0, w1;
        w0.x = pg8::cvt_pk_bf16(ot0[4 * g + 0] * inv, ot0[4 * g + 1] * inv); w0.y = pg8::cvt_pk_bf16(ot0[4 * g + 2] * inv, ot0[4 * g + 3] * inv);
        w1.x = pg8::cvt_pk_bf16(ot1[4 * g + 0] * inv, ot1[4 * g + 1] * inv); w1.y = pg8::cvt_pk_bf16(ot1[4 * g + 2] * inv, ot1[4 * g + 3] * inv);
        *(u32x2*)(Ow + 8 * g + 4 * hi) = w0; *(u32x2*)(Ow + 32 + 8 * g + 4 * hi) = w1;
    }
    __syncthreads();
}


#define SOFTMAX_GROUP(P0, P1, MRUN, LRUN, OT0, OT1, PA) do { \
            float mx = P0[0]; \
            _Pragma("unroll") for (int r = 1; r < 16; ++r) mx = fmaxf(mx, P0[r]); \
            _Pragma("unroll") for (int r = 0; r < 16; ++r) mx = fmaxf(mx, P1[r]); \
            { const auto rr = __builtin_amdgcn_permlane32_swap(__float_as_uint(mx), __float_as_uint(mx), false, false); mx = fmaxf(__uint_as_float(rr[0]), __uint_as_float(rr[1])); } \
            const float mnew = fmaxf(MRUN, mx), sc = __builtin_amdgcn_exp2f(MRUN - mnew); MRUN = mnew; \
            float rs = 0.f; \
            _Pragma("unroll") for (int r = 0; r < 16; ++r) { P0[r] = __builtin_amdgcn_exp2f(P0[r] - mnew); P1[r] = __builtin_amdgcn_exp2f(P1[r] - mnew); rs += P0[r] + P1[r]; } \
            LRUN = LRUN * sc + rs; \
            _Pragma("unroll") for (int r = 0; r < 16; ++r) { OT0[r] *= sc; OT1[r] *= sc; } \
            _Pragma("unroll") for (int s = 0; s < 4; ++s) { u32x4 w; \
                if (s < 2) { w.x = pg8::cvt_pk_bf16(P0[8 * s + 0], P0[8 * s + 1]); w.y = pg8::cvt_pk_bf16(P0[8 * s + 2], P0[8 * s + 3]); w.z = pg8::cvt_pk_bf16(P0[8 * s + 4], P0[8 * s + 5]); w.w = pg8::cvt_pk_bf16(P0[8 * s + 6], P0[8 * s + 7]); } \
                else { const int q = 8 * (s - 2); w.x = pg8::cvt_pk_bf16(P1[q + 0], P1[q + 1]); w.y = pg8::cvt_pk_bf16(P1[q + 2], P1[q + 3]); w.z = pg8::cvt_pk_bf16(P1[q + 4], P1[q + 5]); w.w = pg8::cvt_pk_bf16(P1[q + 6], P1[q + 7]); } \
                PA[s] = __builtin_bit_cast(bf16x8, w); } \
        } while (0)
template <int MODE>
__device__ __forceinline__ void attn_unit2(const bf16* QQ, const bf16* KK, const bf16* VV, bf16* OO, const float* fl2, const float* relb, int b, int h, int qb, LAS unsigned char* lds, float kmax2 = 0.f) {
    const int tid = opq_v((int)threadIdx.x), lane = tid & 63, r32 = lane & 31, hi = lane >> 5, wid = __builtin_amdgcn_readfirstlane(tid >> 6);
    const int hc = (MODE == 0 ? 0 : 512) + h * 64;
    const size_t rowbase = (size_t)b * SEQ; const int q0 = qb * 512;
    int kc0, NT;
    if (MODE == 0) { kc0 = 0; NT = 8 * (qb + 1); } else { kc0 = 8 * qb - 8 < 0 ? 0 : 8 * qb - 8; NT = 8 * qb + 8 - kc0; }
    if (MODE == 0) {
        float qn = 0.f;
        { const bf16* Qn = QQ + (rowbase + q0 + tid) * DM + hc;
#pragma unroll
          for (int c = 0; c < 8; ++c) { const u32x4 v = *(const u32x4*)(Qn + c * 8);
              { const float lo = __uint_as_float(v.x << 16), hh = __uint_as_float(v.x & 0xffff0000u); qn += lo * lo + hh * hh; }
              { const float lo = __uint_as_float(v.y << 16), hh = __uint_as_float(v.y & 0xffff0000u); qn += lo * lo + hh * hh; }
              { const float lo = __uint_as_float(v.z << 16), hh = __uint_as_float(v.z & 0xffff0000u); qn += lo * lo + hh * hh; }
              { const float lo = __uint_as_float(v.w << 16), hh = __uint_as_float(v.w & 0xffff0000u); qn += lo * lo + hh * hh; } } }
#pragma unroll
        for (int o = 32; o >= 1; o >>= 1) qn = fmaxf(qn, __shfl_xor(qn, o));
        LAS float* red = (LAS float*)(lds + AL_MISC); LAS int* t0s = (LAS int*)(lds + AL_MISC + 64);
        if (lane == 0) red[wid] = qn;
        if (tid == 0) *t0s = 8 * qb;
        __syncthreads();
        float q2 = red[0];
#pragma unroll
        for (int w = 1; w < 8; ++w) q2 = fmaxf(q2, red[w]);
        const float thr = 152.0f + 2.002f * sqrtf(q2 * kmax2);
        const float* fl = fl2 + ((size_t)b * 8 + h) * SEQ; const float fq0 = fl[q0];
        if (tid < 8 * qb) { if (fl[64 * tid + 63] - fq0 <= thr) atomicMin((int*)t0s, tid); }
        __syncthreads();
        kc0 = __builtin_amdgcn_readfirstlane(*t0s); NT = 8 * (qb + 1) - kc0;
    }
    const bf16* QwA = QQ + (rowbase + q0 + wid * 64 + r32) * DM + hc; const bf16* QwB = QwA + (size_t)32 * DM;
    bf16x8 qrA[4], qrB[4];
#pragma unroll
    for (int d0 = 0; d0 < 4; ++d0) { qrA[d0] = *(const bf16x8*)(QwA + d0 * 16 + hi * 8); qrB[d0] = *(const bf16x8*)(QwB + d0 * 16 + hi * 8); }
    const int myc = 8 * qb + wid;
    if (MODE == 1) {
        LAS float* rev = (LAS float*)(lds + AL_EXT);
        for (int i = tid; i < 639; i += 512) { int d = 575 - i; d = d > 128 ? 128 : d; rev[i] = LOG2E * relb[h * 257 + d + 128]; }
    }
    const int kvr = tid & 63, ch = tid >> 6;
    const bf16* gK = KK + (rowbase + (size_t)kc0 * 64 + kvr) * DM + hc + ch * 8;
    const bf16* gV = VV + (rowbase + (size_t)kc0 * 64 + kvr) * DM + hc + ch * 8;
    const float* gF = fl2 + ((size_t)b * 8 + h) * SEQ + kc0 * 64 + (tid & 63);
    u32x4 kreg = *(const u32x4*)gK, vreg = *(const u32x4*)gV; float freg = 0.f;
    if (MODE == 0 && tid < 64) freg = *gF;
    float mA = -1e30f, lA = 0.f, mB = -1e30f, lB = 0.f; f32x16 ot0A = {}, ot1A = {}, ot0B = {}, ot1B = {};
    const int qabsA = q0 + wid * 64 + r32, qabsB = qabsA + 32;
    for (int t = 0; t < NT; ++t) {
        const int buf = t & 1;
        {
            *(LAS u32x4*)(lds + AL_K + buf * 8192 + (ch * 64 + kvr) * 16) = kreg;
            LAS unsigned short* vt = (LAS unsigned short*)(lds + AL_VT + buf * 8704) + (ch * 8) * (VT_STRIDE / 2) + kvr;
            vt[0 * 68] = (unsigned short)(vreg.x & 0xffff); vt[1 * 68] = (unsigned short)(vreg.x >> 16);
            vt[2 * 68] = (unsigned short)(vreg.y & 0xffff); vt[3 * 68] = (unsigned short)(vreg.y >> 16);
            vt[4 * 68] = (unsigned short)(vreg.z & 0xffff); vt[5 * 68] = (unsigned short)(vreg.z >> 16);
            vt[6 * 68] = (unsigned short)(vreg.w & 0xffff); vt[7 * 68] = (unsigned short)(vreg.w >> 16);
            if (MODE == 0 && tid < 64) *(LAS float*)(lds + AL_FB + buf * 256 + tid * 4) = freg;
        }
        __syncthreads();
        if (t + 1 < NT) { kreg = *(const u32x4*)(gK + (size_t)(t + 1) * 64 * DM); vreg = *(const u32x4*)(gV + (size_t)(t + 1) * 64 * DM); if (MODE == 0 && tid < 64) freg = gF[(t + 1) * 64]; }
        const int kv0 = (kc0 + t) * 64;
        bool part;
        if (MODE == 0) part = kv0 <= q0 + wid * 64 + 63; else { const int kc = kc0 + t; part = (kc <= myc) && (kc >= myc - 8); }
        if (part) {
            f32x16 p0A = {}, p1A = {}, p0B = {}, p1B = {};
            const LAS unsigned char* kbp = lds + AL_K + buf * 8192 + hi * 1024 + r32 * 16;
#pragma unroll
            for (int d0 = 0; d0 < 4; ++d0) {
                const bf16x8 a0 = *(const LAS bf16x8*)(kbp + d0 * 2048), a1 = *(const LAS bf16x8*)(kbp + d0 * 2048 + 512);
                p0A = __builtin_amdgcn_mfma_f32_32x32x16_bf16(a0, qrA[d0], p0A, 0, 0, 0);
                p1A = __builtin_amdgcn_mfma_f32_32x32x16_bf16(a1, qrA[d0], p1A, 0, 0, 0);
                p0B = __builtin_amdgcn_mfma_f32_32x32x16_bf16(a0, qrB[d0], p0B, 0, 0, 0);
                p1B = __builtin_amdgcn_mfma_f32_32x32x16_bf16(a1, qrB[d0], p1B, 0, 0, 0);
            }
            if (MODE == 0) {
                const LAS float* fb = (const LAS float*)(lds + AL_FB + buf * 256);
#pragma unroll
                for (int g = 0; g < 4; ++g) { const f32x4 f0 = *(const LAS f32x4*)(fb + 8 * g + 4 * hi), f1 = *(const LAS f32x4*)(fb + 32 + 8 * g + 4 * hi);
#pragma unroll
                    for (int e = 0; e < 4; ++e) { p0A[4 * g + e] -= f0[e]; p1A[4 * g + e] -= f1[e]; p0B[4 * g + e] -= f0[e]; p1B[4 * g + e] -= f1[e]; } }
                if (kv0 + 63 > q0 + wid * 64) {
#pragma unroll
                    for (int r = 0; r < 16; ++r) { const int kv = kv0 + crow(r, hi); if (kv > qabsA) p0A[r] = -1e30f; if (kv + 32 > qabsA) p1A[r] = -1e30f; if (kv > qabsB) p0B[r] = -1e30f; if (kv + 32 > qabsB) p1B[r] = -1e30f; }
                }
            } else {
                const LAS float* rvA = (const LAS float*)(lds + AL_EXT) + (575 - (qabsA - kv0) + 4 * hi); const LAS float* rvB = rvA - 32;
#pragma unroll
                for (int r = 0; r < 16; ++r) { const int C = (r & 3) + 8 * (r >> 2); p0A[r] += rvA[C]; p1A[r] += rvA[C + 32]; p0B[r] += rvB[C]; p1B[r] += rvB[C + 32]; }
            }
            bf16x8 paA[4], paB[4];
            SOFTMAX_GROUP(p0A, p1A, mA, lA, ot0A, ot1A, paA);
            SOFTMAX_GROUP(p0B, p1B, mB, lB, ot0B, ot1B, paB);
            const LAS unsigned char* vtb = lds + AL_VT + buf * 8704 + r32 * VT_STRIDE + hi * 8;
#pragma unroll
            for (int s = 0; s < 4; ++s) {
                const u32x2 a_lo = *(const LAS u32x2*)(vtb + s * 32), a_hi = *(const LAS u32x2*)(vtb + s * 32 + 16);
                const u32x2 b_lo = *(const LAS u32x2*)(vtb + 32 * VT_STRIDE + s * 32), b_hi = *(const LAS u32x2*)(vtb + 32 * VT_STRIDE + s * 32 + 16);
                const bf16x8 va = __builtin_bit_cast(bf16x8, (u32x4){a_lo.x, a_lo.y, a_hi.x, a_hi.y}), vb = __builtin_bit_cast(bf16x8, (u32x4){b_lo.x, b_lo.y, b_hi.x, b_hi.y});
                ot0A = __builtin_amdgcn_mfma_f32_32x32x16_bf16(va, paA[s], ot0A, 0, 0, 0);
                ot1A = __builtin_amdgcn_mfma_f32_32x32x16_bf16(vb, paA[s], ot1A, 0, 0, 0);
                ot0B = __builtin_amdgcn_mfma_f32_32x32x16_bf16(va, paB[s], ot0B, 0, 0, 0);
                ot1B = __builtin_amdgcn_mfma_f32_32x32x16_bf16(vb, paB[s], ot1B, 0, 0, 0);
            }
        }
    }
#define STORE_GROUP(LRUN, OT0, OT1, QROW) do { \
        float lt = LRUN; lt += __shfl_xor(lt, 32); const float inv = 1.0f / lt; \
        bf16* Ow = OO + (rowbase + (QROW)) * DM + hc; \
        _Pragma("unroll") for (int g = 0; g < 4; ++g) { u32x2 w0, w1; \
            w0.x = pg8::cvt_pk_bf16(OT0[4 * g + 0] * inv, OT0[4 * g + 1] * inv); w0.y = pg8::cvt_pk_bf16(OT0[4 * g + 2] * inv, OT0[4 * g + 3] * inv); \
            w1.x = pg8::cvt_pk_bf16(OT1[4 * g + 0] * inv, OT1[4 * g + 1] * inv); w1.y = pg8::cvt_pk_bf16(OT1[4 * g + 2] * inv, OT1[4 * g + 3] * inv); \
            *(u32x2*)(Ow + 8 * g + 4 * hi) = w0; *(u32x2*)(Ow + 32 + 8 * g + 4 * hi) = w1; } } while (0)
    STORE_GROUP(lA, ot0A, ot1A, qabsA);
    STORE_GROUP(lB, ot0B, ot1B, qabsB);
#undef STORE_GROUP
    __syncthreads();
}
#undef SOFTMAX_GROUP

__device__ __forceinline__ void knorm_phase(const Args& a, LAS unsigned char* lds, int G, int layer) {
    const int tid = opq_v((int)threadIdx.x), lane = tid & 63, wave = tid >> 6;
    const bf16* KK = (const bf16*)(a.ws + WS_K); unsigned* KN = (unsigned*)(a.ws + WS_KN) + layer * 32;
    LAS float* red = (LAS float*)(lds + AL_MISC);
    for (int item = blockIdx.x; item < 256; item += G) {
        const int bh = item >> 3, part = item & 7;
        const bf16* Kp = KK + ((size_t)(bh >> 3) * SEQ + part * 1024 + wave * 128 + (lane >> 3)) * DM + (bh & 7) * 64 + (lane & 7) * 8;
        float mx = 0.f;
#pragma unroll 4
        for (int it = 0; it < 16; ++it) { const u32x4 v = *(const u32x4*)(Kp + (size_t)it * 8 * DM);
            float s2 = 0.f;
            { const float lo = __uint_as_float(v.x << 16), hi = __uint_as_float(v.x & 0xffff0000u); s2 += lo * lo + hi * hi; }
            { const float lo = __uint_as_float(v.y << 16), hi = __uint_as_float(v.y & 0xffff0000u); s2 += lo * lo + hi * hi; }
            { const float lo = __uint_as_float(v.z << 16), hi = __uint_as_float(v.z & 0xffff0000u); s2 += lo * lo + hi * hi; }
            { const float lo = __uint_as_float(v.w << 16), hi = __uint_as_float(v.w & 0xffff0000u); s2 += lo * lo + hi * hi; }
            s2 += __shfl_xor(s2, 1); s2 += __shfl_xor(s2, 2); s2 += __shfl_xor(s2, 4);
            mx = fmaxf(mx, s2); }
        mx = fmaxf(mx, __shfl_xor(mx, 8)); mx = fmaxf(mx, __shfl_xor(mx, 16)); mx = fmaxf(mx, __shfl_xor(mx, 32));
        if (lane == 0) red[wave] = mx;
        __syncthreads();
        if (tid == 0) { float m = red[0];
#pragma unroll
            for (int w = 1; w < 8; ++w) m = fmaxf(m, red[w]);
            atomicMax(KN + bh, __float_as_uint(m)); }
        __syncthreads();
    }
}
__device__ __forceinline__ void attn_phase(const Args& a, LAS unsigned char* lds, int G, int layer) {
    const bf16* QQ = (const bf16*)(a.ws + WS_QQ); const bf16* KK = (const bf16*)(a.ws + WS_K); const bf16* VV = (const bf16*)(a.ws + WS_V); bf16* OO = (bf16*)(a.ws + WS_QQ);
    const float* fl2 = (const float*)(a.ws + WS_FL2); const float* relb = a.rel_bias + (size_t)layer * 8 * 257;
    {
        unsigned* ctr = (unsigned*)(a.ws + WS_KN) + 64 + layer; const unsigned* KN = (const unsigned*)(a.ws + WS_KN) + layer * 32;
        LAS int* qs = (LAS int*)(lds + AL_MISC + 128);
        for (;;) {
            if (threadIdx.x == 0) *qs = (int)atomicAdd(ctr, 1u);
            __syncthreads();
            const int u = __builtin_amdgcn_readfirstlane(*qs);
            __syncthreads();
            if (u >= 1024) break;
            if (u < 512) { const int bh = u & 31, qb = 15 - (u >> 5);
                attn_unit2<0>(QQ, KK, VV, OO, fl2, relb, bh >> 3, bh & 7, qb, lds, __uint_as_float(KN[bh])); }
            else { const int i = u - 512;
                attn_unit2<1>(QQ, KK, VV, OO, fl2, relb, (i >> 4) >> 3, (i >> 4) & 7, i & 15, lds); }
        }
    }
}

__device__ __forceinline__ void fixup_phase(const Args& a, int G, int layer) {
    const float* HD = (const float*)(a.ws + WS_HD); const float* TL = (const float*)(a.ws + WS_TL); bf16* GF = (bf16*)(a.ws + WS_GFF);
    const float* cw = a.conv_w + (size_t)layer * 3 * NUP; const float* cb = a.conv_b + (size_t)layer * NUP;
    const int total = (T / 64) * 2 * (DFF / 4);
    for (int idx = opq_s((int)blockIdx.x) * 512 + opq_v((int)threadIdx.x); idx < total; idx += G * 512) {
        const int grp = idx / (2 * (DFF / 4)), rem = idx % (2 * (DFF / 4)), e = rem / (DFF / 4), c = (rem % (DFF / 4)) * 4;
        const bool first = (grp % (SEQ / 64)) == 0;
        const f32x4 z = (f32x4){0.f, 0.f, 0.f, 0.f};
        f32x4 u0a, u0v, u1a, u1v, u2a, u2v;
        const float* h0 = HD + (size_t)(grp * 2 + e) * NUP + c; u0a = *(const f32x4*)h0; u0v = *(const f32x4*)(h0 + DFF);
        if (e == 0) {
            if (first) { u1a = z; u1v = z; u2a = z; u2v = z; }
            else { const float* t1 = TL + (size_t)((grp - 1) * 2 + 1) * NUP + c; const float* t0 = TL + (size_t)((grp - 1) * 2) * NUP + c;
                u1a = *(const f32x4*)t1; u1v = *(const f32x4*)(t1 + DFF); u2a = *(const f32x4*)t0; u2v = *(const f32x4*)(t0 + DFF); }
        } else {
            const float* hp = HD + (size_t)(grp * 2) * NUP + c; u1a = *(const f32x4*)hp; u1v = *(const f32x4*)(hp + DFF);
            if (first) { u2a = z; u2v = z; } else { const float* t1 = TL + (size_t)((grp - 1) * 2 + 1) * NUP + c; u2a = *(const f32x4*)t1; u2v = *(const f32x4*)(t1 + DFF); }
        }
        const f32x4 w0a = *(const f32x4*)(cw + c), w1a = *(const f32x4*)(cw + NUP + c), w2a = *(const f32x4*)(cw + 2 * NUP + c), ba = *(const f32x4*)(cb + c);
        const f32x4 w0v = *(const f32x4*)(cw + DFF + c), w1v = *(const f32x4*)(cw + NUP + DFF + c), w2v = *(const f32x4*)(cw + 2 * NUP + DFF + c), bv = *(const f32x4*)(cb + DFF + c);
        const f32x4 ya = ba + w2a * u0a + w1a * u1a + w0a * u2a, yv = bv + w2v * u0v + w1v * u1v + w0v * u2v;
        float g[4];
#pragma unroll
        for (int k = 0; k < 4; ++k) g[k] = ya[k] * pg8::sigmoidf_fast(ya[k]) * yv[k];
        u32x2 w; w.x = pg8::cvt_pk_bf16(g[0], g[1]); w.y = pg8::cvt_pk_bf16(g[2], g[3]);
        *(u32x2*)(GF + (size_t)(grp * 64 + e) * DFF + c) = w;
    }
}


#ifdef SELFCHECK
constexpr size_t WS_DIAG = 512 * 1024;
__device__ __forceinline__ float bf2f(bf16 v) { return __uint_as_float(((unsigned)v) << 16); }
__device__ __forceinline__ void dbg_cmp(const Args& a, int stage, float got, float want, float tol) {
    const float err = fabsf(got - want); if (!(err <= tol * (fabsf(want) + 0.02f))) atomicMin((unsigned*)(a.ws + WS_DIAG), (unsigned)stage);
}
__device__ const int dbg_rows[8] = {0, 70, 1410, 10440, 8209, 8292, 20118, 32767};
__device__ __forceinline__ void selfcheck(const Args& a, int stage, int l) {
    const int tid = threadIdx.x, lane = tid & 63, wave = tid >> 6;
    const float* mod = (const float*)(a.ws + WS_MOD); const bf16* Hb = (const bf16*)(a.ws + WS_H);
    const bf16* Win = (const bf16*)(a.ws + WS_WIN) + (size_t)l * NPROJ * DM;
    float* dexp = (float*)(a.ws + WS_DIAG) + 1024;
    if (stage == 1 && tid < 64) { const int ll = tid & 1, b = (tid >> 1) & 3, j = (tid * 97) % NMOD; double s = a.b_ada[ll * NMOD + j];
        for (int k = 0; k < DM; ++k) { const double c = a.c[b * DM + k]; s += c / (1.0 + exp(-c)) * (double)a.w_ada[((size_t)ll * DM + k) * NMOD + j]; }
        dbg_cmp(a, 1, mod[((size_t)ll * BATCH + b) * NMOD + j], (float)s, 1e-3f); }
    if (stage == 2 && tid < 256) { const int k = (tid * 37) % DM;
        { const int d = (tid * 211) % NPROJ, seg = d >> 9; const int segsrc = seg == 0 ? 0 : seg == 1 ? 1544 : seg == 2 ? 512 : seg == 3 ? 2056 : seg == 4 ? 1024 : seg == 5 ? 2568 : 3080 + (seg - 6) * 512;
          dbg_cmp(a, 2, bf2f(((const bf16*)(a.ws + WS_WIN))[(size_t)d * DM + k]), a.w_in[(size_t)k * PROJ + segsrc + (d & 511)], 5e-3f); }
        { const int n = (tid * 13) % DM; dbg_cmp(a, 2, bf2f(((const bf16*)(a.ws + WS_WBR))[(size_t)n * DM + (k & 511)]), a.w_br_fox[(size_t)(k & 511) * DM + n], 5e-3f);
          dbg_cmp(a, 2, bf2f(((const bf16*)(a.ws + WS_WBR))[(size_t)n * DM + 512 + (k & 511)]), a.w_br_chunk[(size_t)(k & 511) * DM + n], 5e-3f);
          dbg_cmp(a, 2, bf2f(((const bf16*)(a.ws + WS_WOUT))[(size_t)n * DM + k]), a.w_out[(size_t)k * DM + n], 5e-3f);
          const int kk = (tid * 53) % DFF; dbg_cmp(a, 2, bf2f(((const bf16*)(a.ws + WS_WDN))[(size_t)n * DFF + kk]), a.w_down[(size_t)kk * DM + n], 5e-3f); }
        { const int d = (tid * 331) % NUP, pn = d >> 8, bj = (d >> 7) & 1, j = d & 127; dbg_cmp(a, 2, bf2f(((const bf16*)(a.ws + WS_WUP))[(size_t)d * DM + k]), a.w_up[(size_t)k * NUP + bj * DFF + 128 * pn + j], 5e-3f); } }
    if (stage == 3 && tid < 8) { const int row = dbg_rows[tid], b = row / SEQ; const float* x = a.x + (size_t)row * DM; double m = 0, q = 0;
        for (int k = 0; k < DM; ++k) m += x[k]; m /= DM; for (int k = 0; k < DM; ++k) q += (x[k] - m) * (x[k] - m); const double rs = 1.0 / sqrt(q / DM + 1e-5);
        double f[8] = {0, 0, 0, 0, 0, 0, 0, 0};
        for (int k = 0; k < DM; ++k) { const double h = (x[k] - m) * rs * (1.0 + mod[(size_t)b * NMOD + DM + k]) + mod[(size_t)b * NMOD + k];
            if ((k & 63) == 5) dbg_cmp(a, 3, bf2f(Hb[(size_t)row * DM + k]), (float)h, 1e-2f);
            for (int hh = 0; hh < 8; ++hh) f[hh] += h * (double)a.w_in[(size_t)k * PROJ + 1536 + hh]; }
        for (int hh = 0; hh < 8; ++hh) { const double z = f[hh] + a.b_f[hh]; dbg_cmp(a, 3, ((const float*)(a.ws + WS_LF))[(size_t)row * 8 + hh], (float)(-log1p(exp(-z))), 2e-3f); } }
    if (stage == 4 && tid < 32) { const int b = tid >> 3, hh = tid & 7, tt = 5000 + 97 * tid; double s = 0; for (int t = 0; t <= tt; ++t) s += ((const float*)(a.ws + WS_LF))[((size_t)b * SEQ + t) * 8 + hh];
        dbg_cmp(a, 4, ((const float*)(a.ws + WS_FL2))[((size_t)b * 8 + hh) * SEQ + tt], (float)(s * 1.4426950408889634), 1e-4f); }
    if (stage == 5) { unsigned* cnt = (unsigned*)(a.ws + WS_DIAG) + 16;
        for (int it = 0; it < 2; ++it) { const int row = (tid * 61 + it * 4099 + 7) % T, d = 1024 + (tid * 167 + it * 31 + 5) % 2048; const int hot = row & (DM - 1);
            int nz = 0; bool hotok = false; double s2 = 0;
            for (int k = 0; k < DM; ++k) { const float hv = bf2f(Hb[(size_t)row * DM + k]); if (hv != 0.f) ++nz; if (k == hot && hv == 1.0f) hotok = true; s2 += (double)hv * (double)bf2f(Win[(size_t)d * DM + k]); }
            const float got = (d < 2048) ? bf2f(((const bf16*)(a.ws + WS_K))[(size_t)row * DM + d - 1024]) : bf2f(((const bf16*)(a.ws + WS_V))[(size_t)row * DM + d - 2048]);
            atomicAdd(cnt + 0, 1u); if (nz == 1 && hotok) atomicAdd(cnt + 1, 1u); if (fabsf(got - (float)s2) <= 1.5e-2f * (fabsf((float)s2) + 0.02f)) atomicAdd(cnt + 2, 1u); } }
    if (stage == 60 || stage == 6) {
        const int smp = wave, row = dbg_rows[(smp * 3 + 2) & 7], b = row / SEQ, t = row % SEQ, h = (smp * 5 + 1) & 7, band = smp >= 4;
        const int hc = (band ? 512 : 0) + h * 64;
        const bf16* QQ = (const bf16*)(a.ws + WS_QQ); const bf16* KK = (const bf16*)(a.ws + WS_K); const bf16* VV = (const bf16*)(a.ws + WS_V);
        if (stage == 60) {
            const int c = t >> 6; const int s_lo = band ? ((c - 8 < 0 ? 0 : c - 8) << 6) : 0, s_hi = band ? (c << 6) + 63 : t;
            const float qd = bf2f(QQ[((size_t)b * SEQ + t) * DM + hc + lane]);
            float mx = -3e38f, lsum = 0.f, od = 0.f;
            for (int s2 = s_lo; s2 <= s_hi; ++s2) {
                float lg = wave_sum(qd * bf2f(KK[((size_t)b * SEQ + s2) * DM + hc + lane]));
                if (!band) lg -= ((const float*)(a.ws + WS_FL2))[((size_t)b * 8 + h) * SEQ + s2];
                else { int dd = t - s2; dd = dd > 128 ? 128 : (dd < -128 ? -128 : dd); lg += 1.4426950408889634f * a.rel_bias[((size_t)l * 8 + h) * 257 + dd + 128]; }
                const float mn = fmaxf(mx, lg), sc = exp2f(mx - mn), p = exp2f(lg - mn); mx = mn;
                lsum = lsum * sc + p; od = od * sc + p * bf2f(VV[((size_t)b * SEQ + s2) * DM + hc + lane]);
            }
            dexp[smp * 64 + lane] = od / lsum;
        } else if (lane < 64) { dbg_cmp(a, band ? 7 : 6, bf2f(QQ[((size_t)b * SEQ + t) * DM + hc + lane]), dexp[smp * 64 + lane], 3e-2f); }
    }
    if (stage == 80 || stage == 8) {
        if (stage == 8 && tid < 128) { const int row = dbg_rows[tid & 7], n = (tid * 59 + 3) % DM; const bf16* O = (const bf16*)(a.ws + WS_QQ); const bf16* Wbr = (const bf16*)(a.ws + WS_WBR) + (size_t)l * DM * DM;
            double sa = 0, sc = 0; for (int k = 0; k < 512; ++k) { sa += (double)bf2f(O[(size_t)row * DM + k]) * bf2f(Wbr[(size_t)n * DM + k]); sc += (double)bf2f(O[(size_t)row * DM + 512 + k]) * bf2f(Wbr[(size_t)n * DM + 512 + k]); }
            const bf16* GG = (const bf16*)(a.ws + WS_G); const double want = bf2f(GG[(size_t)row * 2048 + n]) * sa + bf2f(GG[(size_t)row * 2048 + 1024 + n]) * sc;
            dbg_cmp(a, 8, bf2f(Hb[(size_t)row * DM + n]), (float)want, 2e-2f); } }
    if (stage == 9 && tid < 128) { const int row = dbg_rows[tid & 7], n = (tid * 59 + 3) % DM; const bf16* Wo = (const bf16*)(a.ws + WS_WOUT) + (size_t)l * DM * DM; double s2 = 0;
        for (int k = 0; k < DM; ++k) s2 += (double)bf2f(Hb[(size_t)row * DM + k]) * bf2f(Wo[(size_t)n * DM + k]);
        dbg_cmp(a, 9, ((const float*)(a.ws + WS_MIX))[(size_t)row * DM + n], (float)s2, 5e-3f); }
    if (stage == 10 && tid < 8) { const int row = dbg_rows[tid], b = row / SEQ; const float* x = a.x + (size_t)row * DM; const float* mx = (const float*)(a.ws + WS_MIX) + (size_t)row * DM; const float* ml = mod + (size_t)b * NMOD;
        double m = 0, q = 0; for (int k = 0; k < DM; ++k) m += 1.4142135623730951 * x[k] + (1.0 + ml[2 * DM + k]) * mx[k]; m /= DM;
        for (int k = 0; k < DM; ++k) { const double v = 1.4142135623730951 * x[k] + (1.0 + ml[2 * DM + k]) * mx[k] - m; q += v * v; } const double rs = 1.0 / sqrt(q / DM + 1e-5);
        double m2 = 0, q2 = 0;
        for (int k = 0; k < DM; ++k) { const double x1 = (1.4142135623730951 * x[k] + (1.0 + ml[2 * DM + k]) * mx[k] - m) * rs * a.ln1_g[k] + a.ln1_b[k]; m2 += x1; if ((k & 31) == 3) dbg_cmp(a, 10, a.out[(size_t)row * DM + k], (float)x1, 1e-3f); } m2 /= DM;
        for (int k = 0; k < DM; ++k) { const double x1 = a.out[(size_t)row * DM + k]; q2 += (x1 - m2) * (x1 - m2); } const double rs2 = 1.0 / sqrt(q2 / DM + 1e-5);
        for (int k = 5; k < DM; k += 64) { const double h2 = (a.out[(size_t)row * DM + k] - m2) * rs2 * (1.0 + ml[4 * DM + k]) + ml[3 * DM + k]; dbg_cmp(a, 10, bf2f(Hb[(size_t)row * DM + k]), (float)h2, 1e-2f); } }
    if (stage == 11 && tid < 256) { const int row = dbg_rows[tid & 7], c = (tid * 89 + 7) % DFF, spos = row % SEQ; const bf16* Wu = (const bf16*)(a.ws + WS_WUP) + (size_t)l * NUP * DM;
        const int da = (c >> 7) * 256 + (c & 127), dv = da + 128; double ya = a.conv_b[c], yv = a.conv_b[DFF + c];
        for (int j = 0; j < 3; ++j) { const int sp = spos - 2 + j; if (sp < 0) continue; const size_t r2 = (size_t)row - 2 + j; double ua = 0, uv = 0;
            for (int k = 0; k < DM; ++k) { const double hv = bf2f(Hb[r2 * DM + k]); ua += hv * bf2f(Wu[(size_t)da * DM + k]); uv += hv * bf2f(Wu[(size_t)dv * DM + k]); }
            ya += a.conv_w[j * NUP + c] * ua; yv += a.conv_w[j * NUP + DFF + c] * uv; }
        dbg_cmp(a, 11, bf2f(((const bf16*)(a.ws + WS_GFF))[(size_t)row * DFF + c]), (float)(ya / (1.0 + exp(-ya)) * yv), 2e-2f); }
    if (stage == 12 && tid < 128) { const int row = dbg_rows[tid & 7], n = (tid * 59 + 3) % DM; const bf16* Wd = (const bf16*)(a.ws + WS_WDN) + (size_t)l * DM * DFF; const bf16* GF = (const bf16*)(a.ws + WS_GFF); double s2 = 0;
        for (int k = 0; k < DFF; ++k) s2 += (double)bf2f(GF[(size_t)row * DFF + k]) * bf2f(Wd[(size_t)n * DFF + k]);
        dbg_cmp(a, 12, ((const float*)(a.ws + WS_Y))[(size_t)row * DM + n], (float)s2, 5e-3f); }
    __syncthreads();
}
#define SC(st) do {} while (0)
#else
#define SC(st) do {} while (0)
#endif


constexpr size_t WS_BAR = 768 * 1024;
constexpr unsigned BAR_POISON = 0xAAAAAAAAu, NBAR = 32u;
__device__ __forceinline__ void gbar(unsigned* bw, unsigned k) {
    asm volatile("s_waitcnt vmcnt(0) lgkmcnt(0)" ::: "memory");
    __syncthreads();
    if (threadIdx.x == 0) {
        __builtin_amdgcn_fence(__ATOMIC_RELEASE, "agent");
        asm volatile("s_waitcnt vmcnt(0)" ::: "memory");
        unsigned zz = 0u; asm volatile("" : "+v"(zz));
        const unsigned G = gridDim.x + zz, g = (blockIdx.x + zz) & 7u;
        const unsigned ng = (G >> 3) + ((g < (G & 7u)) ? 1u : 0u), ngrp = G < 8u ? G : 8u;
        unsigned* cg = bw + 64u * g; unsigned* top = bw + 64u * 8u; unsigned* rel = bw + 64u * 9u;
        const unsigned per1 = NBAR * ng, perT = NBAR * ngrp;
        const unsigned nowT = __hip_atomic_load(top, __ATOMIC_RELAXED, __HIP_MEMORY_SCOPE_AGENT);
        const unsigned baseT = BAR_POISON + ((nowT - BAR_POISON) / perT) * perT;
        const unsigned relTarget = baseT + (k + 1u) * ngrp;
        const unsigned old = __hip_atomic_fetch_add(cg, 1u, __ATOMIC_RELAXED, __HIP_MEMORY_SCOPE_AGENT);
        const unsigned base1 = BAR_POISON + ((old - BAR_POISON) / per1) * per1;
        if (old + 1u == base1 + (k + 1u) * ng) {
            const unsigned oldT = __hip_atomic_fetch_add(top, 1u, __ATOMIC_RELAXED, __HIP_MEMORY_SCOPE_AGENT);
            if (oldT + 1u == relTarget) __hip_atomic_store(rel, relTarget, __ATOMIC_RELAXED, __HIP_MEMORY_SCOPE_AGENT);
        }
        while ((int)(__hip_atomic_load(rel, __ATOMIC_RELAXED, __HIP_MEMORY_SCOPE_AGENT) - relTarget) < 0) __builtin_amdgcn_s_sleep(1);
        __builtin_amdgcn_fence(__ATOMIC_ACQUIRE, "agent");
        asm volatile("s_waitcnt vmcnt(0)" ::: "memory");
    }
    __syncthreads();
}
__device__ __forceinline__ void gbar_pad(unsigned* bw, unsigned nb) {
    if (threadIdx.x == 0) {
        const unsigned G = gridDim.x, g = blockIdx.x & 7u, ngrp = G < 8u ? G : 8u;
        __hip_atomic_fetch_add(bw + 64u * g, NBAR - nb, __ATOMIC_RELAXED, __HIP_MEMORY_SCOPE_AGENT);
        if (blockIdx.x < ngrp) __hip_atomic_fetch_add(bw + 64u * 8u, NBAR - nb, __ATOMIC_RELAXED, __HIP_MEMORY_SCOPE_AGENT);
    }
}

template <int PHM_T> __global__ void __launch_bounds__(NWAVES * 64, 2) fwd_megakernel_t(Args a_unused) {
    extern __shared__ __attribute__((aligned(16))) unsigned char lds_raw[];
    LAS unsigned char* lds = (LAS unsigned char*)lds_raw;
    cg::grid_group grid = cg::this_grid();
#ifdef MULTI
#define GSYNCK(K) do {} while (0)
#else
#define GSYNCK(K) do { KArgP apb_ = (KArgP)__builtin_amdgcn_kernarg_segment_ptr(); asm volatile("" : "+s"(apb_)); gbar((unsigned*)(apb_->ws + WS_BAR), (K)); } while (0)
#endif
    unsigned bar_idx = 0u; (void)bar_idx;
#ifndef MULTI
    grid.sync();
#endif
    typedef const __attribute__((address_space(4))) Args* KArgP;
#if defined(__HIP_DEVICE_COMPILE__)
#define FRESH_ARGS() KArgP ap_ = (KArgP)__builtin_amdgcn_kernarg_segment_ptr(); asm volatile("" : "+s"(ap_)); Args a; \
    a.x = ap_->x; a.c = ap_->c; a.w_in = ap_->w_in; a.b_f = ap_->b_f; a.rel_bias = ap_->rel_bias; a.w_br_fox = ap_->w_br_fox; a.w_br_chunk = ap_->w_br_chunk; a.w_out = ap_->w_out; a.w_up = ap_->w_up; \
    a.conv_w = ap_->conv_w; a.conv_b = ap_->conv_b; a.w_down = ap_->w_down; a.w_ada = ap_->w_ada; a.b_ada = ap_->b_ada; a.ln1_g = ap_->ln1_g; a.ln1_b = ap_->ln1_b; a.ln2_g = ap_->ln2_g; a.ln2_b = ap_->ln2_b; \
    a.out = ap_->out; a.ws = ap_->ws; a.phm = ap_->phm; a.pad = 0; const int G = opq_s((int)gridDim.x); const int BX = opq_s(BX); \
    const float* mod = (const float*)(a.ws + WS_MOD); bf16* Hb = (bf16*)(a.ws + WS_H); (void)mod; (void)Hb; (void)BX
#else
#define FRESH_ARGS() const Args a = a_unused; const int G = 1, BX = 0; const float* mod = nullptr; bf16* Hb = nullptr; (void)mod; (void)Hb; (void)BX
#endif

#ifdef MULTI
    const int phm_rt = a_unused.phm, l_lo = a_unused.pad & 0xff, l_hi = a_unused.pad >> 8;
#define PHM phm_rt
#else
#define PHM PHM_T
#endif
    { FRESH_ARGS();
      if (blockIdx.x == 0 && threadIdx.x < 128) ((unsigned*)(a.ws + WS_KN))[threadIdx.x] = 0u;
      if (PHM & 1) mod_phase(a, lds, G); if (PHM & 2) weights_phase(a, lds, G); }
    GSYNCK(0u);
    { const int l = 0; SC(1); SC(2); }
    { FRESH_ARGS(); if (PHM & 4) ln_pass<false, true, true>(a, lds, G, a.x, nullptr, nullptr, nullptr, nullptr, nullptr, mod + 1 * DM, mod + 0 * DM, 0); }
    GSYNCK(1u);
#ifdef SELFCHECK_ONEHOT_DISABLED
    { FRESH_ARGS(); for (size_t i = (size_t)blockIdx.x * 512 + threadIdx.x; i < (size_t)T * DM / 2; i += (size_t)G * 512) { const int row = (int)(i / (DM / 2)), k2 = (int)(i % (DM / 2)) * 2; const int hot = row & (DM - 1); ((unsigned*)Hb)[i] = (k2 == hot) ? 0x00003F80u : (k2 + 1 == hot) ? 0x3F800000u : 0u; } }
    GSYNCK(999u);
#endif

#ifndef NL_RUN
#define NL_RUN NL
#endif
#ifdef MULTI
    for (int l = l_lo; l < l_hi; ++l) {
#else
    for (int l = 0; l < NL_RUN; ++l) {
#endif
        { FRESH_ARGS(); if (PHM & 8) scan_phase(a, lds, G); }
        __syncthreads();
        if (PHM & 16) { FRESH_ARGS();
#ifdef SELFCHECK
            for (int zi = threadIdx.x; zi < 131072 / 4; zi += 512) ((LAS unsigned*)lds)[zi] = 0u; __syncthreads();
#endif
            pg8::Gemm g{Hb, (const bf16*)(a.ws + WS_WIN) + (size_t)l * NPROJ * DM, T, NPROJ, DM, DM, DM};
            pg8::StaticOrder S; S.init(T, NPROJ, (int)gridDim.x, (int)blockIdx.x);
            pg8::EpiProj E{(bf16*)(a.ws + WS_QQ), (bf16*)(a.ws + WS_K), (bf16*)(a.ws + WS_V), (bf16*)(a.ws + WS_G)};
            pg8::gemm_phase<pg8::EpiProj, pg8::StaticOrder, true, true>(lds, g, S, E);
        }
        GSYNCK((2u + 10u * (unsigned)l + 0u));
        SC(4); SC(5); SC(60);
        { FRESH_ARGS(); if (PHM & 32) knorm_phase(a, lds, G, l); }
        GSYNCK((2u + 10u * (unsigned)l + 1u));
        { FRESH_ARGS(); if (PHM & 32) attn_phase(a, lds, G, l); }
        GSYNCK((2u + 10u * (unsigned)l + 2u));
        SC(6);
        if (PHM & 64) {
            FRESH_ARGS();
            pg8::Gemm g{(const bf16*)(a.ws + WS_QQ), (const bf16*)(a.ws + WS_WBR) + (size_t)l * DM * DM, T, DM, DM, DM, DM};
            pg8::StaticOrder S; S.init(T, DM, (int)gridDim.x, (int)blockIdx.x);
            pg8::EpiMergeK E{Hb, (const bf16*)(a.ws + WS_G)};
            pg8::gemm_phase<pg8::EpiMergeK, pg8::StaticOrder, true, true>(lds, g, S, E);
        }
        GSYNCK((2u + 10u * (unsigned)l + 3u));
        SC(8);
        if (PHM & 128) {
            FRESH_ARGS();
            pg8::Gemm g{Hb, (const bf16*)(a.ws + WS_WOUT) + (size_t)l * DM * DM, T, DM, DM, DM, DM};
            pg8::StaticOrder S; S.init(T, DM, (int)gridDim.x, (int)blockIdx.x);
            pg8::EpiBf16P E{(bf16*)(a.ws + WS_MIX), DM};
            pg8::gemm_phase<pg8::EpiBf16P, pg8::StaticOrder, true, true>(lds, g, S, E);
        }
        GSYNCK((2u + 10u * (unsigned)l + 4u));
        SC(9);
        if (PHM & 256) { FRESH_ARGS(); const float* modl = mod + (size_t)l * BATCH * NMOD; const float* xcur = (l == 0) ? a.x : a.out;
            ln_pass<true, true, false>(a, lds, G, xcur, (const bf16*)(a.ws + WS_MIX), a.out, modl + 2 * DM, a.ln1_g + l * DM, a.ln1_b + l * DM, modl + 4 * DM, modl + 3 * DM, 0); }
        GSYNCK((2u + 10u * (unsigned)l + 5u));
        SC(10);
        if (PHM & 512) {
            FRESH_ARGS();
            pg8::Gemm g{Hb, (const bf16*)(a.ws + WS_WUP) + (size_t)l * NUP * DM, T, NUP, DM, DM, DM};
            pg8::StaticOrder S; S.init(T, NUP, (int)gridDim.x, (int)blockIdx.x);
            pg8::EpiUp E{(bf16*)(a.ws + WS_GFF), (float*)(a.ws + WS_HD), (float*)(a.ws + WS_TL), a.conv_w + (size_t)l * 3 * NUP, a.conv_b + (size_t)l * NUP};
            pg8::gemm_phase<pg8::EpiUp, pg8::StaticOrder, true, true>(lds, g, S, E);
        }
        GSYNCK((2u + 10u * (unsigned)l + 6u));
        { FRESH_ARGS(); if (PHM & 1024) fixup_phase(a, G, l); }
        GSYNCK((2u + 10u * (unsigned)l + 7u));
        SC(11);
        if (PHM & 2048) {
            FRESH_ARGS();
            pg8::Gemm g{(const bf16*)(a.ws + WS_GFF), (const bf16*)(a.ws + WS_WDN) + (size_t)l * DM * DFF, T, DM, DFF, DFF, DFF};
            pg8::StaticOrder S; S.init(T, DM, (int)gridDim.x, (int)blockIdx.x);
            pg8::EpiBf16P E{(bf16*)(a.ws + WS_Y), DM};
            pg8::gemm_phase<pg8::EpiBf16P, pg8::StaticOrder, true, true>(lds, g, S, E);
        }
        GSYNCK((2u + 10u * (unsigned)l + 8u));
        SC(12);
        if (l + 1 < NL) {
            { FRESH_ARGS(); const float* modl = mod + (size_t)l * BATCH * NMOD; const float* modn = mod + (size_t)(l + 1) * BATCH * NMOD;
            if (PHM & 4096) ln_pass<true, true, true>(a, lds, G, a.out, (const bf16*)(a.ws + WS_Y), a.out, modl + 5 * DM, a.ln2_g + l * DM, a.ln2_b + l * DM, modn + 1 * DM, modn + 0 * DM, l + 1); }
            GSYNCK((2u + 10u * (unsigned)l + 9u));
        } else {
            FRESH_ARGS(); const float* modl = mod + (size_t)l * BATCH * NMOD;
            if (PHM & 8192) ln_pass<true, false, false>(a, lds, G, a.out, (const bf16*)(a.ws + WS_Y), a.out, modl + 5 * DM, a.ln2_g + l * DM, a.ln2_b + l * DM, nullptr, nullptr, 0);
        }
    }
#ifndef MULTI
    { KArgP apb_ = (KArgP)__builtin_amdgcn_kernarg_segment_ptr(); asm volatile("" : "+s"(apb_)); gbar_pad((unsigned*)(apb_->ws + WS_BAR), 2u + 10u * (unsigned)NL - 1u); }
#endif
}


#ifdef SELFCHECK
__global__ void __launch_bounds__(512) check_kernel(Args a, int which) {
    if (which == 0) { if (threadIdx.x < 128) ((unsigned*)(a.ws + WS_DIAG))[threadIdx.x] = threadIdx.x == 0 ? 1000u : 0u; return; }
    if (which == 1) { selfcheck(a, 5, 0); }
    if (which == 2) { selfcheck(a, 9, 0); }
    if (which == 6) { selfcheck(a, 8, 0); }
    if (which == 3) selfcheck(a, 10, 0);
    if (which == 4) selfcheck(a, 11, 0);
    if (which == 5) selfcheck(a, 12, 0);
    if (which == 9) { if (threadIdx.x == 0) { const unsigned dg = *(volatile unsigned*)(a.ws + WS_DIAG); if (dg < 1000u) a.out[0] = 1e4f * (float)dg; const unsigned* cnt = (const unsigned*)(a.ws + WS_DIAG) + 16; int mant = (int)(99.f * (float)cnt[1] / (float)(cnt[0] + 1u)); mant = mant < 10 ? 10 : mant; int ex = (int)(10.f * (float)cnt[2] / (float)(cnt[0] + 1u) + 0.5f); a.out[0] = (float)mant * __powf(10.f, 2.f + (float)ex); } }
}
#endif

#ifdef SELFCHECK
__global__ void __launch_bounds__(512) dma_test(unsigned char* ws) {
    extern __shared__ __attribute__((aligned(16))) unsigned char lds_raw2[];
    LAS unsigned char* lds = (LAS unsigned char*)lds_raw2;
    const int tid = threadIdx.x, wid = __builtin_amdgcn_readfirstlane(tid >> 6), lane = tid & 63;
    unsigned* src = (unsigned*)(ws + 600 * 1024);
    for (int i = tid; i < 32768; i += 512) src[i] = (unsigned)i * 2654435761u;
    for (int i = tid; i < 131072 / 4; i += 512) ((LAS unsigned*)lds)[i] = 0u;
    __threadfence(); __syncthreads();
    const unsigned bases[6] = {0u, 0x6000u, 0xE000u, 0x10000u, 0x16000u, 0x1E000u};
    unsigned bad = 0;
#pragma unroll
    for (int b = 0; b < 6; ++b) {
        __builtin_amdgcn_global_load_lds((const unsigned*)((const char*)src + b * 8192 + tid * 16), (LAS unsigned*)(lds + bases[b] + wid * 1024), 16, 0, 0);
    }
    asm volatile("s_waitcnt vmcnt(0)" ::: "memory"); __syncthreads();
#pragma unroll
    for (int b = 0; b < 6; ++b) {
        const u32x4 v = *(const LAS u32x4*)(lds + bases[b] + tid * 16);
        const unsigned w0 = (unsigned)(b * 2048 + tid * 4);
        if (v.x != w0 * 2654435761u || v.y != (w0 + 1) * 2654435761u || v.z != (w0 + 2) * 2654435761u || v.w != (w0 + 3) * 2654435761u) bad |= 1u << b;
    }
    if (bad) atomicOr((unsigned*)(ws + WS_DIAG) + 100, bad);
}
#endif

#ifdef SELFCHECK
struct OneUnit { __device__ bool next(int i, pg8::Unit& u) const { if (i > 0) return false; u.pm = 0; u.pn = 0; return true; }
                 __device__ void a_ready(const pg8::Unit&) const {} __device__ void done(const pg8::Unit&) const {} };
__global__ void __launch_bounds__(512, 2) engine_test(unsigned char* ws) {
    extern __shared__ __attribute__((aligned(16))) unsigned char lds_raw3[];
    LAS unsigned char* lds = (LAS unsigned char*)lds_raw3;
    bf16* A = (bf16*)(ws + 8 * MiB); bf16* B = A + 256 * 128; float* C0 = (float*)(ws + 9 * MiB); float* C1 = C0 + 65536;
    const int tid = threadIdx.x;
    for (int i = tid; i < 256 * 128; i += 512) { const int m = i >> 7, k = i & 127; A[i] = (bf16)f2bf((float)((m * 7 + k * 3) % 13 - 6) * 0.125f); B[i] = (bf16)f2bf((float)((m * 5 + k) % 11 - 5) * 0.125f); }
    __threadfence(); __syncthreads();
    pg8::Gemm g{A, B, 256, 256, 128, 128, 128}; OneUnit S;
    { pg8::EpiF32 E{C0, 256}; pg8::sgemm_phase<pg8::EpiF32, OneUnit>(lds, g, S, E); }
    __threadfence(); __syncthreads();
    { pg8::EpiF32 E{C1, 256}; pg8::gemm_phase<pg8::EpiF32, OneUnit, true, true>(lds, g, S, E); }
    __threadfence(); __syncthreads();
    unsigned ok0 = 0, ok1 = 0;
    for (int i = tid; i < 65536; i += 512) { const int m = i >> 8, n = i & 255; float s2 = 0.f;
        for (int k = 0; k < 128; ++k) s2 += (float)((m * 7 + k * 3) % 13 - 6) * 0.125f * ((float)((n * 5 + k) % 11 - 5) * 0.125f);
        if (fabsf(C0[i] - s2) < 1e-3f) ++ok0; if (fabsf(C1[i] - s2) < 1e-3f) ++ok1; }
    atomicAdd((unsigned*)(ws + WS_DIAG) + 110, ok0); atomicAdd((unsigned*)(ws + WS_DIAG) + 111, ok1);
}
#endif

#ifdef SEPK
#define SEPK_LDS() extern __shared__ __attribute__((aligned(16))) unsigned char lds_rawk[]; LAS unsigned char* lds = (LAS unsigned char*)lds_rawk; const int G = gridDim.x; const int BX = blockIdx.x; (void)G; (void)BX; const float* mod = (const float*)(a.ws + WS_MOD); bf16* Hb = (bf16*)(a.ws + WS_H); (void)mod; (void)Hb
__global__ void __launch_bounds__(512, 2) k_prologue(Args a) { SEPK_LDS(); mod_phase(a, lds, G); weights_phase(a, lds, G); }
__global__ void __launch_bounds__(512, 2) k_ln0(Args a) { SEPK_LDS(); ln_pass<false, true, true>(a, lds, G, a.x, nullptr, nullptr, nullptr, nullptr, nullptr, mod + 1 * DM, mod + 0 * DM, 0); }
__global__ void __launch_bounds__(512, 2) k_scan(Args a) { SEPK_LDS(); scan_phase(a, lds, G); }
__global__ void __launch_bounds__(512, 2) k_proj(Args a, int l) { SEPK_LDS();
    pg8::Gemm g{Hb, (const bf16*)(a.ws + WS_WIN) + (size_t)l * NPROJ * DM, T, NPROJ, DM, DM, DM}; pg8::StaticOrder S; S.init(T, NPROJ, (int)gridDim.x, (int)blockIdx.x);
    pg8::EpiProj E{(bf16*)(a.ws + WS_QQ), (bf16*)(a.ws + WS_K), (bf16*)(a.ws + WS_V), (bf16*)(a.ws + WS_G)}; pg8::gemm_phase<pg8::EpiProj, pg8::StaticOrder, true, true>(lds, g, S, E); }
__global__ void __launch_bounds__(512, 2) k_attn(Args a, int l) { SEPK_LDS(); attn_phase(a, lds, G, l); }
__global__ void __launch_bounds__(512, 2) k_merge(Args a, int l) { SEPK_LDS();
    pg8::Gemm g{(const bf16*)(a.ws + WS_QQ), (const bf16*)(a.ws + WS_WBR) + (size_t)l * DM * DM, T, DM, DM, DM, DM}; pg8::StaticOrder S; S.init(T, DM, (int)gridDim.x, (int)blockIdx.x);
    pg8::EpiMergeK E{Hb, (const bf16*)(a.ws + WS_G)}; pg8::gemm_phase<pg8::EpiMergeK, pg8::StaticOrder, true, true>(lds, g, S, E); }
__global__ void __launch_bounds__(512, 2) k_out(Args a, int l) { SEPK_LDS();
    pg8::Gemm g{Hb, (const bf16*)(a.ws + WS_WOUT) + (size_t)l * DM * DM, T, DM, DM, DM, DM}; pg8::StaticOrder S; S.init(T, DM, (int)gridDim.x, (int)blockIdx.x);
    pg8::EpiF32 E{(float*)(a.ws + WS_MIX), DM}; pg8::gemm_phase<pg8::EpiF32, pg8::StaticOrder, true, true>(lds, g, S, E); }
__global__ void __launch_bounds__(512, 2) k_lnmid(Args a, int l) { SEPK_LDS(); const float* modl = mod + (size_t)l * BATCH * NMOD; const float* xcur = (l == 0) ? a.x : a.out;
    ln_pass<true, true, false>(a, lds, G, xcur, (const bf16*)(a.ws + WS_MIX), a.out, modl + 2 * DM, a.ln1_g + l * DM, a.ln1_b + l * DM, modl + 4 * DM, modl + 3 * DM, 0); }
__global__ void __launch_bounds__(512, 2) k_up(Args a, int l) { SEPK_LDS();
    pg8::Gemm g{Hb, (const bf16*)(a.ws + WS_WUP) + (size_t)l * NUP * DM, T, NUP, DM, DM, DM}; pg8::StaticOrder S; S.init(T, NUP, (int)gridDim.x, (int)blockIdx.x);
    pg8::EpiUp E{(bf16*)(a.ws + WS_GFF), (float*)(a.ws + WS_HD), (float*)(a.ws + WS_TL), a.conv_w + (size_t)l * 3 * NUP, a.conv_b + (size_t)l * NUP}; pg8::gemm_phase<pg8::EpiUp, pg8::StaticOrder, true, true>(lds, g, S, E); }
__global__ void __launch_bounds__(512, 2) k_fixup(Args a, int l) { SEPK_LDS(); fixup_phase(a, G, l); }
__global__ void __launch_bounds__(512, 2) k_down(Args a, int l) { SEPK_LDS();
    pg8::Gemm g{(const bf16*)(a.ws + WS_GFF), (const bf16*)(a.ws + WS_WDN) + (size_t)l * DM * DFF, T, DM, DFF, DFF, DFF}; pg8::StaticOrder S; S.init(T, DM, (int)gridDim.x, (int)blockIdx.x);
    pg8::EpiF32 E{(float*)(a.ws + WS_Y), DM}; pg8::gemm_phase<pg8::EpiF32, pg8::StaticOrder, true, true>(lds, g, S, E); }
__global__ void __launch_bounds__(512, 2) k_lnend(Args a, int l) { SEPK_LDS(); const float* modl = mod + (size_t)l * BATCH * NMOD;
    if (l + 1 < NL) { const float* modn = mod + (size_t)(l + 1) * BATCH * NMOD;
        ln_pass<true, true, true>(a, lds, G, a.out, (const bf16*)(a.ws + WS_Y), a.out, modl + 5 * DM, a.ln2_g + l * DM, a.ln2_b + l * DM, modn + 1 * DM, modn + 0 * DM, l + 1); }
    else ln_pass<true, false, false>(a, lds, G, a.out, (const bf16*)(a.ws + WS_Y), a.out, modl + 5 * DM, a.ln2_g + l * DM, a.ln2_b + l * DM, nullptr, nullptr, 0); }
#endif
#ifndef PHM_A
#define PHM_A 0x3ffff
#endif
#define MK_MAIN fwd_megakernel_t<PHM_A>

#ifdef SELFCHECK
__global__ void __launch_bounds__(512, 2) proj_test(Args a) {
    extern __shared__ __attribute__((aligned(16))) unsigned char lds_raw4[];
    LAS unsigned char* lds = (LAS unsigned char*)lds_raw4;
    pg8::Gemm g{(const bf16*)(a.ws + WS_H), (const bf16*)(a.ws + WS_WIN), T, NPROJ, DM, DM, DM};
    pg8::StaticOrder S; S.init(T, NPROJ, (int)gridDim.x, (int)blockIdx.x);
    pg8::EpiProj E{(bf16*)(a.ws + WS_QQ), (bf16*)(a.ws + WS_K), (bf16*)(a.ws + WS_V), (bf16*)(a.ws + WS_G)};
    pg8::gemm_phase<pg8::EpiProj, pg8::StaticOrder, true, true>(lds, g, S, E);
}
#endif

#ifdef DETCHECK
constexpr size_t WS_DET = 512 * 1024;
__global__ void __launch_bounds__(512) cksum_kernel(const unsigned* p, size_t nwords, const unsigned* p2, size_t nwords2, unsigned* slot) {
    unsigned s = 0u;
    for (size_t i = (size_t)blockIdx.x * 512 + threadIdx.x; i < nwords; i += (size_t)gridDim.x * 512) s += p[i] * 2654435761u + (unsigned)i;
    for (size_t i = (size_t)blockIdx.x * 512 + threadIdx.x; i < nwords2; i += (size_t)gridDim.x * 512) s += p2[i] * 40503u + (unsigned)i;
#pragma unroll
    for (int o = 1; o < 64; o <<= 1) s += __shfl_xor(s, o);
    if ((threadIdx.x & 63) == 0) atomicAdd(slot, s);
}
__global__ void det_init(unsigned* slots) { if (threadIdx.x < 64) slots[threadIdx.x] = 0u; }
__global__ void det_report(const unsigned* slots, float* out) { if (threadIdx.x == 0) { for (int i = 0; i < 20; ++i) if (slots[i] != slots[20 + i]) { out[0] = 1e4f * (float)(i + 1); break; } } }
#endif
extern "C" void kernel_launch(void* const* d_in, const int* in_sizes, int n_in, void* d_out, int out_size, void* d_ws, size_t ws_size, hipStream_t stream) {
    static int grid = 0;
    if (grid == 0) {
        if (n_in != 18 || in_sizes[0] != T * DM || out_size != T * DM || ws_size < WS_END) { fprintf(stderr, "kernel_launch: unexpected shapes (n_in %d, in0 %d, out %d, ws %zu)\n", n_in, n_in > 0 ? in_sizes[0] : -1, out_size, ws_size); grid = -1; return; }
        int dev = 0, cus = 0, per_cu = 0;
        if (hipGetDevice(&dev) != hipSuccess || hipDeviceGetAttribute(&cus, hipDeviceAttributeMultiprocessorCount, dev) != hipSuccess) { grid = -1; return; }
        if (hipFuncSetAttribute((const void*)MK_MAIN, hipFuncAttributeMaxDynamicSharedMemorySize, LDS_BYTES) != hipSuccess) { fprintf(stderr, "kernel_launch: hipFuncSetAttribute failed\n"); grid = -1; return; }
        if (hipOccupancyMaxActiveBlocksPerMultiprocessor(&per_cu, (const void*)MK_MAIN, NWAVES * 64, LDS_BYTES) != hipSuccess || per_cu < 1) per_cu = 1;
        (void)hipGetLastError();
        grid = cus;
    }
    if (grid < 0) return;
    Args a{};
    a.x = (const float*)d_in[0]; a.c = (const float*)d_in[1]; a.w_in = (const float*)d_in[2]; a.b_f = (const float*)d_in[3]; a.rel_bias = (const float*)d_in[4];
    a.w_br_fox = (const float*)d_in[5]; a.w_br_chunk = (const float*)d_in[6]; a.w_out = (const float*)d_in[7]; a.w_up = (const float*)d_in[8]; a.conv_w = (const float*)d_in[9];
    a.conv_b = (const float*)d_in[10]; a.w_down = (const float*)d_in[11]; a.w_ada = (const float*)d_in[12]; a.b_ada = (const float*)d_in[13];
    a.ln1_g = (const float*)d_in[14]; a.ln1_b = (const float*)d_in[15]; a.ln2_g = (const float*)d_in[16]; a.ln2_b = (const float*)d_in[17];
    a.out = (float*)d_out; a.ws = (unsigned char*)d_ws;
    void* args[] = {&a};
    (void)hipMemsetAsync((unsigned char*)d_ws + WS_BAR, 0xAA, 64 * 10 * 4, stream);
#ifdef SELFCHECK
    hipLaunchKernelGGL(check_kernel, dim3(1), dim3(512), 0, stream, a, 0);
    (void)hipFuncSetAttribute((const void*)dma_test, hipFuncAttributeMaxDynamicSharedMemorySize, LDS_BYTES);
    hipLaunchKernelGGL(dma_test, dim3(1), dim3(512), LDS_BYTES, stream, (unsigned char*)d_ws);
    (void)hipFuncSetAttribute((const void*)engine_test, hipFuncAttributeMaxDynamicSharedMemorySize, LDS_BYTES);
    hipLaunchKernelGGL(engine_test, dim3(1), dim3(512), LDS_BYTES, stream, (unsigned char*)d_ws);
    { hipError_t e = hipLaunchCooperativeKernel((const void*)MK_MAIN, dim3(grid), dim3(NWAVES * 64), args, LDS_BYTES, stream);
      if (e != hipSuccess) fprintf(stderr, "cooperative launch failed: %s (grid %d)\n", hipGetErrorString(e), grid); }
#ifdef PHM_B
    { (void)hipFuncSetAttribute((const void*)fwd_megakernel_t<PHM_B>, hipFuncAttributeMaxDynamicSharedMemorySize, LDS_BYTES); hipError_t e = hipLaunchCooperativeKernel((const void*)fwd_megakernel_t<PHM_B>, dim3(grid), dim3(NWAVES * 64), args, LDS_BYTES, stream);
      if (e != hipSuccess) fprintf(stderr, "cooperative launch B failed: %s\n", hipGetErrorString(e)); }
#endif
#ifdef PROJTEST
    (void)hipFuncSetAttribute((const void*)proj_test, hipFuncAttributeMaxDynamicSharedMemorySize, LDS_BYTES);
    hipLaunchKernelGGL(proj_test, dim3(256), dim3(512), LDS_BYTES, stream, a);
#endif
    hipLaunchKernelGGL(check_kernel, dim3(1), dim3(512), 0, stream, a, SELFCHECK);
    hipLaunchKernelGGL(check_kernel, dim3(1), dim3(512), 0, stream, a, 9);
#elif defined(SEPK)
    {
#define LK(k, ...) do { static bool once_##k = false; if (!once_##k) { (void)hipFuncSetAttribute((const void*)k, hipFuncAttributeMaxDynamicSharedMemorySize, LDS_BYTES); once_##k = true; } hipLaunchKernelGGL(k, dim3(grid), dim3(512), LDS_BYTES, stream, __VA_ARGS__); } while (0)
        LK(k_prologue, a); LK(k_ln0, a);
        for (int l = 0; l < NL; ++l) { LK(k_scan, a); LK(k_proj, a, l); LK(k_attn, a, l); LK(k_merge, a, l); LK(k_out, a, l); LK(k_lnmid, a, l); LK(k_up, a, l); LK(k_fixup, a, l); LK(k_down, a, l); LK(k_lnend, a, l); }
    }
    if (0) {
#elif defined(MULTI)
    {
        const int seq[][3] = {{3, 0, 0}, {4, 0, 0},
            {24, 0, 1}, {32, 0, 1}, {64, 0, 1}, {128, 0, 1}, {256, 0, 1}, {512, 0, 1}, {1024, 0, 1}, {2048, 0, 1}, {4096, 0, 1},
            {24, 1, 2}, {32, 1, 2}, {64, 1, 2}, {128, 1, 2}, {256, 1, 2}, {512, 1, 2}, {1024, 1, 2}, {2048, 1, 2}, {8192, 1, 2}};
#ifdef DETCHECK
        hipLaunchKernelGGL(det_init, dim3(1), dim3(64), 0, stream, (unsigned*)((unsigned char*)d_ws + WS_DET));
        for (int run = 0; run < 2; ++run)
        for (int i = 0; i < 20; ++i) { a.phm = seq[i][0]; a.pad = seq[i][1] | (seq[i][2] << 8);
            hipLaunchKernelGGL(MK_MAIN, dim3(grid), dim3(NWAVES * 64), LDS_BYTES, stream, a);
            hipLaunchKernelGGL(cksum_kernel, dim3(1024), dim3(512), 0, stream, (const unsigned*)((unsigned char*)d_ws + MiB), (size_t)(449 * MiB / 4), (const unsigned*)d_out, (size_t)T * DM, (unsigned*)((unsigned char*)d_ws + WS_DET) + run * 20 + i); }
        hipLaunchKernelGGL(det_report, dim3(1), dim3(64), 0, stream, (const unsigned*)((unsigned char*)d_ws + WS_DET), (float*)d_out);
#else
        for (int i = 0; i < 20; ++i) { a.phm = seq[i][0]; a.pad = seq[i][1] | (seq[i][2] << 8);
            hipLaunchKernelGGL(MK_MAIN, dim3(grid), dim3(NWAVES * 64), LDS_BYTES, stream, a); }
#endif
    }
    if (0) {
#else
    a.phm = 0x3ffff;
    hipError_t e = hipLaunchCooperativeKernel((const void*)MK_MAIN, dim3(grid), dim3(NWAVES * 64), args, LDS_BYTES, stream);
    if (e != hipSuccess) fprintf(stderr, "cooperative launch failed: %s (grid %d)\n", hipGetErrorString(e), grid);
#endif
#if defined(MULTI) || defined(SEPK)
    }
#endif
}
```
